# Optimizing an MI355X kernel written in HIP

```python
import math
import jax
import jax.numpy as jnp
from jax import lax
import numpy as np

D_MODEL = 1024
BATCH = 32
SEQ = 256
DEPTH = 2
DEC_BATCH = 4
DEC_SEQ = 2048
PAST_LEN = 256

GRID_W = 64
ROPE_THETA = 10000.0
EPS = 1e-6
Q_BLOCK = 128
N_MOD = 9
D_FF = 2816

DA_HEADS = 6
DA_QK = 32
DA_V = 2 * DA_QK
DA_WIDTH = DA_HEADS * DA_V
MLA_HEADS = 6
MLA_Q_RANK = 256
MLA_KV_RANK = 128
MLA_NOPE = 64
MLA_ROPE = 32
MLA_V = 64
MLA_WIDTH = MLA_HEADS * MLA_V
S5_WIDTH = D_MODEL - DA_WIDTH - MLA_WIDTH
S5_CH = 16
S5_GROUPS = S5_WIDTH // S5_CH
S5_STATE = 64

MIX_WIDTH = DA_WIDTH + MLA_WIDTH + S5_WIDTH
IN_SIZES = (DA_HEADS * 2 * DA_QK, DA_HEADS * 2 * DA_QK, DA_WIDTH, MLA_Q_RANK, MLA_KV_RANK, MLA_ROPE, S5_WIDTH)
IN_COLS = 3 * DA_WIDTH + MLA_Q_RANK + MLA_KV_RANK + MLA_ROPE + S5_WIDTH

kernel_name = 'hybrid_dit_diffattn_mla_s5_step'

F32 = jnp.float32


def rms_norm(x, w):
    xf = x.astype(F32)
    y = xf * lax.rsqrt(jnp.mean(xf * xf, axis=-1, keepdims=True) + EPS)
    return (y * w.astype(F32)).astype(x.dtype)


def modulate(h, shift, scale):
    return h * (1.0 + scale) + shift


def swiglu(h, w_in, w_out):
    a, g = jnp.split(h @ w_in, 2, axis=-1)
    return (jax.nn.silu(g) * a) @ w_out


def adaln(cvec, l, p):
    m = jax.nn.silu(cvec) @ p['w_ada'][l] + p['b_ada'][l]
    return m.reshape(cvec.shape[0], N_MOD, D_MODEL)


def grid_positions(n):
    rows = n // GRID_W
    row = jnp.repeat(jnp.arange(rows, dtype=jnp.int32), GRID_W)
    col = jnp.tile(jnp.arange(GRID_W, dtype=jnp.int32), rows)
    return row, col


def _rope_axis(x, pos):
    n = x.shape[-1] // 2
    inv = ROPE_THETA ** (-jnp.arange(n, dtype=F32) / n)
    ang = pos.astype(F32)[:, None] * inv[None, :]
    shape = (1, ang.shape[0]) + (1,) * (x.ndim - 3) + (n,)
    cos = jnp.cos(ang).reshape(shape).astype(x.dtype)
    sin = jnp.sin(ang).reshape(shape).astype(x.dtype)
    x1, x2 = x[..., :n], x[..., n:]
    return jnp.concatenate([x1 * cos - x2 * sin, x1 * sin + x2 * cos], axis=-1)


def rope_2d(x, pos):
    row, col = pos
    h = x.shape[-1] // 2
    return jnp.concatenate([_rope_axis(x[..., :h], row), _rope_axis(x[..., h:], col)], axis=-1)


def sweep_queries(fn, q):
    b, s = q.shape[:2]
    qb = jnp.moveaxis(q.reshape((b, s // Q_BLOCK, Q_BLOCK) + q.shape[2:]), 1, 0)
    out = jnp.moveaxis(lax.map(fn, qb), 0, 1)
    return out.reshape((b, s) + out.shape[3:])


def diff_attention(q, k, v, lam):
    scale = DA_QK ** -0.5
    def block(qb):
        s = jnp.einsum('bqhcd,bkhcd->bhcqk', qb, k).astype(F32) * scale
        pr = jax.nn.softmax(s, axis=-1)
        w = pr[:, :, 0] - lam * pr[:, :, 1]
        return jnp.einsum('bhqk,bkhd->bqhd', w.astype(v.dtype), v)
    return sweep_queries(block, q)


def softmax_attention(q, k, v, scale):
    def block(qb):
        s = jnp.einsum('bqhd,bkhd->bhqk', qb, k).astype(F32) * scale
        pr = jax.nn.softmax(s, axis=-1)
        return jnp.einsum('bhqk,bkhd->bqhd', pr.astype(v.dtype), v)
    return sweep_queries(block, q)


def diff_mixer(q, k, v, l, p, pos, ctx_k, ctx_v):
    b, s = q.shape[:2]
    q = q.reshape(b, s, DA_HEADS, 2, DA_QK)
    k = k.reshape(b, s, DA_HEADS, 2, DA_QK)
    v = v.reshape(b, s, DA_HEADS, DA_V)
    new = (k.reshape(b, s, DA_HEADS, 2 * DA_QK), v)
    if pos is None:
        k_all, v_all = k, v
    else:
        q = rope_2d(q, pos)
        kc = ctx_k.reshape(ctx_k.shape[0], ctx_k.shape[1], DA_HEADS, 2, DA_QK)
        k_all = jnp.concatenate([rope_2d(k, pos), kc.astype(k.dtype)], axis=1)
        v_all = jnp.concatenate([v, ctx_v.astype(v.dtype)], axis=1)
    lam_init = 0.8 - 0.6 * math.exp(-0.3 * l)
    lp = p['diff_lambda'][l].astype(F32)
    lam = jnp.exp(jnp.sum(lp[0] * lp[1])) - jnp.exp(jnp.sum(lp[2] * lp[3])) + lam_init
    o = diff_attention(q, k_all, v_all, lam)
    o = rms_norm(o, p['diff_subln_w'][l]) * (1.0 - lam_init)
    return o.reshape(b, s, DA_WIDTH), new


def mla_expand(ckv, kpe, l, p):
    b, s = ckv.shape[:2]
    kv = (ckv @ p['mla_w_kv_up'][l]).reshape(b, s, MLA_HEADS, MLA_NOPE + MLA_V)
    k_pe = jnp.broadcast_to(kpe[:, :, None, :].astype(kv.dtype), (b, s, MLA_HEADS, MLA_ROPE))
    return jnp.concatenate([kv[..., :MLA_NOPE], k_pe], axis=-1), kv[..., MLA_NOPE:]


def mla_mixer(cq, ckv, kpe, l, p, pos, ctx_ckv, ctx_kpe):
    b, s = cq.shape[:2]
    q = (rms_norm(cq, p['mla_q_norm_w'][l]) @ p['mla_w_q_up'][l]).reshape(b, s, MLA_HEADS, MLA_NOPE + MLA_ROPE)
    ckv = rms_norm(ckv, p['mla_kv_norm_w'][l])
    new = (ckv, kpe)
    if pos is None:
        k, v = mla_expand(ckv, kpe, l, p)
    else:
        q = jnp.concatenate([q[..., :MLA_NOPE], rope_2d(q[..., MLA_NOPE:], pos)], axis=-1)
        kpe_r = rope_2d(kpe[:, :, None, :], pos)[:, :, 0]
        k_l, v_l = mla_expand(ckv, kpe_r, l, p)
        k_c, v_c = mla_expand(ctx_ckv.astype(ckv.dtype), ctx_kpe, l, p)
        k = jnp.concatenate([k_l, k_c], axis=1)
        v = jnp.concatenate([v_l, v_c], axis=1)
    o = softmax_attention(q, k, v, (MLA_NOPE + MLA_ROPE) ** -0.5)
    return o.reshape(b, s, MLA_WIDTH), new


def _ssm_combine(e1, e2):
    a1, b1 = e1
    a2, b2 = e2
    return a2 * a1, a2 * b1 + b2


def s5_mixer(u, l, p, h0_re, h0_im):
    b, n = u.shape[:2]
    uf = u.astype(F32).reshape(b, n, S5_GROUPS, S5_CH)
    uc = uf.astype(jnp.complex64)
    lam = lax.complex(p['s5_a_re'][l].astype(F32), p['s5_a_im'][l].astype(F32))
    step = jnp.exp(p['s5_log_step'][l].astype(F32))[..., None]
    lam_bar = jnp.exp(lam * step)
    b_mat = lax.complex(p['s5_b_re'][l].astype(F32), p['s5_b_im'][l].astype(F32))
    b_bar = ((lam_bar - 1.0) / lam)[..., None] * b_mat
    c_mat = lax.complex(p['s5_c_re'][l].astype(F32), p['s5_c_im'][l].astype(F32))
    y = p['s5_d'][l].astype(F32) * uf
    finals = []
    for d, rev in ((0, False), (1, True)):
        bu = jnp.einsum('gpc,blgc->blgp', b_bar[d], uc)
        if h0_re is not None:
            h_init = lax.complex(h0_re[:, d].astype(F32), h0_im[:, d].astype(F32))
            edge = n - 1 if rev else 0
            bu = bu.at[:, edge].add(lam_bar[d] * h_init)
        a = jnp.broadcast_to(lam_bar[d], bu.shape)
        _, h = lax.associative_scan(_ssm_combine, (a, bu), axis=1, reverse=rev)
        y = y + jnp.real(jnp.einsum('gcp,blgp->blgc', c_mat[d], h))
        finals.append(h[:, 0] if rev else h[:, -1])
    y = jax.nn.gelu(y.reshape(b, n, S5_WIDTH))
    out = y * jax.nn.sigmoid(y @ p['s5_w_glu'][l].astype(F32) + p['s5_b_glu'][l].astype(F32))
    fin = jnp.stack(finals, axis=1)
    return out.astype(u.dtype), jnp.real(fin), jnp.imag(fin)


def mixer(h, l, p, pos, ctx):
    offs = np.cumsum(np.array(IN_SIZES))[:-1].tolist()
    qa, ka, va, cq, ckv, kpe, u = jnp.split(h @ p['w_in'][l], offs, axis=-1)
    if ctx is None:
        ctx = (None,) * 6
    o_a, new_a = diff_mixer(qa, ka, va, l, p, pos, ctx[0], ctx[1])
    o_b, new_b = mla_mixer(cq, ckv, kpe, l, p, pos, ctx[2], ctx[3])
    o_c, s_re, s_im = s5_mixer(u, l, p, ctx[4], ctx[5])
    out = jnp.concatenate([o_a, o_b, o_c], axis=-1) @ p['w_out'][l]
    return out, new_a + new_b + (s_re, s_im)


def trunk_layer(x, mod, l, p, pos, ctx):
    sh1, sc1, g1, sh2, sc2, g2, sh3, sc3, g3 = [mod[:, i, None, :] for i in range(N_MOD)]
    nw = p['norm_w'][l]
    x = x + 0.5 * g1 * swiglu(modulate(rms_norm(x, nw[0]), sh1, sc1), p['ffn_w_in'][l, 0], p['ffn_w_out'][l, 0])
    m, new_ctx = mixer(modulate(rms_norm(x, nw[1]), sh2, sc2), l, p, pos, ctx)
    x = x + g2 * m
    x = x + 0.5 * g3 * swiglu(modulate(rms_norm(x, nw[2]), sh3, sc3), p['ffn_w_in'][l, 1], p['ffn_w_out'][l, 1])
    return x, new_ctx


def setup_inputs(seed: int = 0) -> dict:
    key = jax.random.key(seed)
    ks = iter(jax.random.split(key, 48))
    def nrm(shape, s):
        return jax.random.normal(next(ks), shape, F32) * s
    def gain(shape):
        return 1.0 + nrm(shape, 0.01)
    a_im0 = jnp.pi * jnp.arange(S5_STATE, dtype=F32)
    return {
        'x_prompt': nrm((BATCH, SEQ, D_MODEL), 1.0),
        'x_sample': nrm((DEC_BATCH, DEC_SEQ, D_MODEL), 1.0),
        'cache_diff_k': nrm((DEC_BATCH, DEPTH, PAST_LEN, DA_HEADS, 2 * DA_QK), 1.0),
        'cache_diff_v': nrm((DEC_BATCH, DEPTH, PAST_LEN, DA_HEADS, DA_V), 1.0),
        'cache_mla_ckv': nrm((DEC_BATCH, DEPTH, PAST_LEN, MLA_KV_RANK), 1.0),
        'cache_mla_kpe': nrm((DEC_BATCH, DEPTH, PAST_LEN, MLA_ROPE), 1.0),
        'state_s5_re': nrm((DEC_BATCH, DEPTH, 2, S5_GROUPS, S5_STATE), 1.0),
        'state_s5_im': nrm((DEC_BATCH, DEPTH, 2, S5_GROUPS, S5_STATE), 1.0),
        'c': nrm((DEC_BATCH, D_MODEL), 1.0),
        'c_ctx': nrm((D_MODEL,), 1.0),
        'w_ada': nrm((DEPTH, D_MODEL, N_MOD * D_MODEL), 0.5 * D_MODEL ** -0.5),
        'b_ada': nrm((DEPTH, N_MOD * D_MODEL), 0.01),
        'norm_w': gain((DEPTH, 3, D_MODEL)),
        'ffn_w_in': nrm((DEPTH, 2, D_MODEL, 2 * D_FF), D_MODEL ** -0.5),
        'ffn_w_out': nrm((DEPTH, 2, D_FF, D_MODEL), D_FF ** -0.5),
        'w_in': nrm((DEPTH, D_MODEL, IN_COLS), D_MODEL ** -0.5),
        'diff_lambda': nrm((DEPTH, 4, DA_QK), 0.1),
        'diff_subln_w': gain((DEPTH, DA_V)),
        'mla_q_norm_w': gain((DEPTH, MLA_Q_RANK)),
        'mla_w_q_up': nrm((DEPTH, MLA_Q_RANK, MLA_HEADS * (MLA_NOPE + MLA_ROPE)), MLA_Q_RANK ** -0.5),
        'mla_kv_norm_w': gain((DEPTH, MLA_KV_RANK)),
        'mla_w_kv_up': nrm((DEPTH, MLA_KV_RANK, MLA_HEADS * (MLA_NOPE + MLA_V)), MLA_KV_RANK ** -0.5),
        's5_a_re': -0.5 + nrm((DEPTH, 2, S5_GROUPS, S5_STATE), 0.01),
        's5_a_im': a_im0 + nrm((DEPTH, 2, S5_GROUPS, S5_STATE), 0.01),
        's5_log_step': jax.random.uniform(next(ks), (DEPTH, 2, S5_GROUPS), F32, math.log(1e-3), math.log(1e-1)),
        's5_b_re': nrm((DEPTH, 2, S5_GROUPS, S5_STATE, S5_CH), (2 * S5_CH) ** -0.5),
        's5_b_im': nrm((DEPTH, 2, S5_GROUPS, S5_STATE, S5_CH), (2 * S5_CH) ** -0.5),
        's5_c_re': nrm((DEPTH, 2, S5_GROUPS, S5_CH, S5_STATE), (2 * S5_STATE) ** -0.5),
        's5_c_im': nrm((DEPTH, 2, S5_GROUPS, S5_CH, S5_STATE), (2 * S5_STATE) ** -0.5),
        's5_d': nrm((DEPTH, S5_GROUPS, S5_CH), 1.0),
        's5_w_glu': nrm((DEPTH, S5_WIDTH, S5_WIDTH), S5_WIDTH ** -0.5),
        's5_b_glu': nrm((DEPTH, S5_WIDTH), 0.01),
        'w_out': nrm((DEPTH, MIX_WIDTH, D_MODEL), MIX_WIDTH ** -0.5),
        'final_norm_w': gain((D_MODEL,)),
    }


def reference(x_prompt, x_sample, cache_diff_k, cache_diff_v, cache_mla_ckv, cache_mla_kpe, state_s5_re, state_s5_im, c, c_ctx, w_ada, b_ada, norm_w, ffn_w_in, ffn_w_out, w_in, diff_lambda, diff_subln_w, mla_q_norm_w, mla_w_q_up, mla_kv_norm_w, mla_w_kv_up, s5_a_re, s5_a_im, s5_log_step, s5_b_re, s5_b_im, s5_c_re, s5_c_im, s5_d, s5_w_glu, s5_b_glu, w_out, final_norm_w):
    p = dict(w_ada=w_ada, b_ada=b_ada, norm_w=norm_w, ffn_w_in=ffn_w_in, ffn_w_out=ffn_w_out, w_in=w_in,
             diff_lambda=diff_lambda, diff_subln_w=diff_subln_w, mla_q_norm_w=mla_q_norm_w,
             mla_w_q_up=mla_w_q_up, mla_kv_norm_w=mla_kv_norm_w, mla_w_kv_up=mla_w_kv_up,
             s5_a_re=s5_a_re, s5_a_im=s5_a_im, s5_log_step=s5_log_step, s5_b_re=s5_b_re, s5_b_im=s5_b_im,
             s5_c_re=s5_c_re, s5_c_im=s5_c_im, s5_d=s5_d, s5_w_glu=s5_w_glu, s5_b_glu=s5_b_glu, w_out=w_out)

    x = x_prompt
    ctx_out = []
    for l in range(DEPTH):
        x, new_ctx = trunk_layer(x, adaln(c_ctx[None, :], l, p), l, p, None, None)
        ctx_out.append(new_ctx)
    y_prompt = rms_norm(x, final_norm_w)
    new_diff_k = jnp.stack([t[0] for t in ctx_out], axis=1)
    new_diff_v = jnp.stack([t[1] for t in ctx_out], axis=1)
    new_mla_ckv = jnp.stack([t[2] for t in ctx_out], axis=1)
    new_mla_kpe = jnp.stack([t[3] for t in ctx_out], axis=1)
    new_s5_re = jnp.stack([t[4] for t in ctx_out], axis=1)
    new_s5_im = jnp.stack([t[5] for t in ctx_out], axis=1)

    pos = grid_positions(x_sample.shape[1])
    x = x_sample
    for l in range(DEPTH):
        ctx = (cache_diff_k[:, l], cache_diff_v[:, l], cache_mla_ckv[:, l], cache_mla_kpe[:, l],
               state_s5_re[:, l], state_s5_im[:, l])
        x, _ = trunk_layer(x, adaln(c, l, p), l, p, pos, ctx)
    y_sample = rms_norm(x, final_norm_w)

    return (y_prompt, y_sample, new_diff_k, new_diff_v, new_mla_ckv, new_mla_kpe, new_s5_re, new_s5_im)
```

```cpp
#include <hip/hip_runtime.h>
#include <hip/hip_cooperative_groups.h>
#include <cstdio>
#include <cstdint>
namespace cg = cooperative_groups;

namespace pg8 {
#define PG8_LAS __attribute__((address_space(3)))
typedef unsigned short bf16_t;
typedef short bf16x8 __attribute__((ext_vector_type(8)));
typedef float f32x4 __attribute__((ext_vector_type(4)));
typedef unsigned u32x4 __attribute__((ext_vector_type(4)));
constexpr int BM = 256, BK = 64, HALF = 128, HTB = HALF * BK * 2  , STAGE_BYTES = 8 * HTB, NXCD = 8, WGM = 8;

__host__ __device__ __forceinline__ int lds_byte(int r, int c) { const int st = (r >> 4) * 2 + (c >> 5), rr = r & 15, cc = c & 31, ob = rr * 64 + cc * 2; return st * 1024 + (ob ^ (((ob >> 9) & 1) << 5)); }
__host__ __device__ __forceinline__ void stage_rc(int b, int& R, int& C) { const int st = b / 1024, sb = b % 1024, swz = sb ^ (((sb >> 9) & 1) << 5); R = (st >> 1) * 16 + swz / 64; C = (st & 1) * 32 + (swz % 64) / 2; }
__host__ __device__ __forceinline__ int perm32(int rho) { const int n = rho >> 4, i = rho & 15; return 8 * (i >> 2) + 4 * n + (i & 3); }

struct Unit { int pm, pn; };
struct Gemm { const bf16_t* A; const bf16_t* Bt; int M, N, K, lda, ldb; };

struct StaticOrder {
    int nM, nN, nwg, G, c;
    __host__ __device__ void init(int M, int N, int G_, int c_) { nM = M / BM; nN = N / BM; nwg = nM * nN; G = G_; c = c_; }
    __host__ __device__ bool next(int i, Unit& u) const {
        const long L = (long)i * G + c; if (L >= nwg) return false;
        int wgid = (int)L; { const int q = nwg / NXCD, r = nwg % NXCD, xcd = wgid % NXCD, off = wgid / NXCD; wgid = (xcd < r ? xcd * (q + 1) : r * (q + 1) + (xcd - r) * q) + off; }
        const int nig = WGM * nN, gid = wgid / nig, fm = gid * WGM, gsz = (nM - fm) < WGM ? (nM - fm) : WGM;
        u.pm = fm + ((wgid % nig) % gsz); u.pn = (wgid % nig) / gsz; return true;
    }
    __device__ __forceinline__ void a_ready(const Unit&) const {}
    __device__ __forceinline__ void done(const Unit&) const {}
};
struct GroupOrder {
    int n, G, c;
    __device__ bool next(int i, Unit& u) const { const int L = i * G + c; if (L >= n) return false; u.pm = L; u.pn = L >> 2; return true; }
    __device__ __forceinline__ void a_ready(const Unit&) const {}
    __device__ __forceinline__ void done(const Unit&) const {}
};
__device__ __forceinline__ unsigned cvt_pk_bf16(float lo, float hi) { unsigned r; asm volatile("v_cvt_pk_bf16_f32 %0, %1, %2" : "=v"(r) : "v"(lo), "v"(hi)); return r; }
__device__ __forceinline__ float fsigmoid(float z) { return __builtin_amdgcn_rcpf(1.0f + __expf(-z)); }
struct EpiBf16 {
    static constexpr bool PERM = true, AFTER_DRAIN = false;
    bf16_t* O; int ldc;
    __device__ __forceinline__ void operator()(const f32x4 (&acc)[2][2][4][2], const Unit& u, int wr, int wc, int fr, int fq) const {
        const int row0 = u.pm * BM + wr * 64 + fr; const int col0 = u.pn * BM + wc * 32 + 8 * fq;
#pragma unroll
        for (int ai = 0; ai < 2; ++ai)
#pragma unroll
            for (int m = 0; m < 4; ++m) { bf16_t* rowp = O + (size_t)(row0 + ai * HALF + m * 16) * ldc + col0;
#pragma unroll
                for (int bj = 0; bj < 2; ++bj) { const f32x4 v0 = acc[ai][bj][m][0], v1 = acc[ai][bj][m][1];
                    u32x4 w; w.x = cvt_pk_bf16(v0[0], v0[1]); w.y = cvt_pk_bf16(v0[2], v0[3]); w.z = cvt_pk_bf16(v1[0], v1[1]); w.w = cvt_pk_bf16(v1[2], v1[3]);
                    *(u32x4*)(rowp + bj * HALF) = w; } }
    }
};
struct EpiSwiglu {
    static constexpr bool PERM = true, AFTER_DRAIN = false;
    bf16_t* H;
    __device__ __forceinline__ void operator()(const f32x4 (&acc)[2][2][4][2], const Unit& u, int wr, int wc, int fr, int fq) const {
        const int row0 = u.pm * BM + wr * 64 + fr; const int col0 = u.pn * HALF + wc * 32 + 8 * fq;
#pragma unroll
        for (int ai = 0; ai < 2; ++ai)
#pragma unroll
            for (int m = 0; m < 4; ++m) { bf16_t* rowp = H + (size_t)(row0 + ai * HALF + m * 16) * 2816 + col0;
                float h[8];
#pragma unroll
                for (int n = 0; n < 2; ++n) { const f32x4 av = acc[ai][0][m][n], gv = acc[ai][1][m][n];
#pragma unroll
                    for (int e = 0; e < 4; ++e) h[4 * n + e] = av[e] * gv[e] * fsigmoid(gv[e]); }
                u32x4 w; w.x = cvt_pk_bf16(h[0], h[1]); w.y = cvt_pk_bf16(h[2], h[3]); w.z = cvt_pk_bf16(h[4], h[5]); w.w = cvt_pk_bf16(h[6], h[7]);
                *(u32x4*)rowp = w; }
    }
};
struct EpiResid {
    static constexpr bool PERM = false, AFTER_DRAIN = false;
    const float* resA; const float* resB; float* out; const float* gate; float gs;
    __device__ __forceinline__ void operator()(const f32x4 (&acc)[2][2][4][2], const Unit& u, int wr, int wc, int fr, int fq) const {
        const int row0 = u.pm * BM + wr * 64 + fr; const int col0 = u.pn * BM + wc * 32 + 4 * fq;
        const int cond = (u.pm < 32) ? 0 : 1 + ((u.pm - 32) >> 3);
        const float* gp = gate + (size_t)cond * 9216 + col0;
        f32x4 gv[2][2];
#pragma unroll
        for (int bj = 0; bj < 2; ++bj)
#pragma unroll
            for (int n = 0; n < 2; ++n) gv[bj][n] = *(const f32x4*)(gp + bj * HALF + n * 16) * gs;
#pragma unroll
        for (int ai = 0; ai < 2; ++ai)
#pragma unroll
            for (int m = 0; m < 4; ++m) { const int row = row0 + ai * HALF + m * 16;
                const float* rp = (row < 8192 ? resA + (size_t)row * 1024 : resB + (size_t)(row - 8192) * 1024) + col0; float* op = out + (size_t)row * 1024 + col0;
#pragma unroll
                for (int bj = 0; bj < 2; ++bj)
#pragma unroll
                    for (int n = 0; n < 2; ++n) { const f32x4 r = *(const f32x4*)(rp + bj * HALF + n * 16); *(f32x4*)(op + bj * HALF + n * 16) = r + gv[bj][n] * acc[ai][bj][m][n]; } }
    }
};
struct EpiS5State {
    static constexpr bool PERM = false, AFTER_DRAIN = false;
    float* S;
    __device__ __forceinline__ void operator()(const f32x4 (&acc)[2][2][4][2], const Unit& u, int wr, int wc, int fr, int fq) const {
        const int row0 = u.pm * BM + wr * 64 + fr; const int col0 = wc * 32 + 4 * fq;
#pragma unroll
        for (int ai = 0; ai < 2; ++ai)
#pragma unroll
            for (int m = 0; m < 4; ++m) { float* op = S + (size_t)(row0 + ai * HALF + m * 16) * 256 + col0;
#pragma unroll
                for (int bj = 0; bj < 2; ++bj)
#pragma unroll
                    for (int n = 0; n < 2; ++n) *(f32x4*)(op + bj * HALF + n * 16) = acc[ai][bj][m][n]; }
    }
};
__device__ __forceinline__ float gelu_tanh(float x) { const float z = 1.5957691216f * (x + 0.044715f * x * x * x); return x * fsigmoid(z); }
struct EpiS5Y {
    static constexpr bool PERM = true, AFTER_DRAIN = false;
    bf16_t* YG;
    __device__ __forceinline__ void operator()(const f32x4 (&acc)[2][2][4][2], const Unit& u, int wr, int wc, int fr, int fq) const {
        const int row0 = (u.pm & 3) * BM + wr * 64 + fr; const int g = u.pn;
#pragma unroll
        for (int ai = 0; ai < 2; ++ai)
#pragma unroll
            for (int m = 0; m < 4; ++m) { const int rloc = row0 + ai * HALF + m * 16;
#pragma unroll
                for (int bj = 0; bj < 2; ++bj) { const int j = bj * HALF + wc * 32 + 8 * fq; const int tok = rloc * 16 + (j >> 4);
                    const f32x4 v0 = acc[ai][bj][m][0], v1 = acc[ai][bj][m][1];
                    u32x4 w; w.x = cvt_pk_bf16(gelu_tanh(v0[0]), gelu_tanh(v0[1])); w.y = cvt_pk_bf16(gelu_tanh(v0[2]), gelu_tanh(v0[3]));
                    w.z = cvt_pk_bf16(gelu_tanh(v1[0]), gelu_tanh(v1[1])); w.w = cvt_pk_bf16(gelu_tanh(v1[2]), gelu_tanh(v1[3]));
                    *(u32x4*)(YG + (size_t)tok * 256 + g * 16 + (j & 15)) = w; } }
    }
};
struct EpiGlu {
    static constexpr bool PERM = true, AFTER_DRAIN = false;
    const bf16_t* YG; const float* bias; bf16_t* O;
    __device__ __forceinline__ void operator()(const f32x4 (&acc)[2][2][4][2], const Unit& u, int wr, int wc, int fr, int fq) const {
        const int row0 = u.pm * BM + wr * 64 + fr; const int col0 = wc * 32 + 8 * fq;
#pragma unroll
        for (int ai = 0; ai < 2; ++ai)
#pragma unroll
            for (int m = 0; m < 4; ++m) { const int row = row0 + ai * HALF + m * 16;
#pragma unroll
                for (int bj = 0; bj < 2; ++bj) { const int col = col0 + bj * HALF;
                    const u32x4 y = *(const u32x4*)(YG + (size_t)row * 256 + col);
                    const f32x4 b0 = *(const f32x4*)(bias + col), b1 = *(const f32x4*)(bias + col + 4);
                    const f32x4 v0 = acc[ai][bj][m][0] + b0, v1 = acc[ai][bj][m][1] + b1;
                    float yy[8]; yy[0] = __uint_as_float(y.x << 16); yy[1] = __uint_as_float(y.x & 0xffff0000u); yy[2] = __uint_as_float(y.y << 16); yy[3] = __uint_as_float(y.y & 0xffff0000u);
                    yy[4] = __uint_as_float(y.z << 16); yy[5] = __uint_as_float(y.z & 0xffff0000u); yy[6] = __uint_as_float(y.w << 16); yy[7] = __uint_as_float(y.w & 0xffff0000u);
                    u32x4 w; w.x = cvt_pk_bf16(yy[0] * fsigmoid(v0[0]), yy[1] * fsigmoid(v0[1])); w.y = cvt_pk_bf16(yy[2] * fsigmoid(v0[2]), yy[3] * fsigmoid(v0[3]));
                    w.z = cvt_pk_bf16(yy[4] * fsigmoid(v1[0]), yy[5] * fsigmoid(v1[1])); w.w = cvt_pk_bf16(yy[6] * fsigmoid(v1[2]), yy[7] * fsigmoid(v1[3]));
                    *(u32x4*)(O + (size_t)row * 1024 + 768 + col) = w; asm volatile("" ::: "memory"); } }
    }
};

template <class Epi, class Sched, bool ALIGN_EPI = false, bool SP2 = false>
__device__ __forceinline__ void gemm_phase(PG8_LAS unsigned char* lds, const Gemm g, const Sched& S, const Epi& E, int tid_in) {
    int tid_ = tid_in; asm volatile("" : "+v"(tid_));
    const int tid = tid_, wid = __builtin_amdgcn_readfirstlane(tid >> 6), lane = tid & 63, wr = wid >> 2, wc = wid & 3, fr = lane & 15, fq = lane >> 4;
    int K_ = g.K; asm volatile("" : "+s"(K_));
    const int K = K_, nt = K / BK;
    unsigned voffA[2], voffB[2];
#pragma unroll
    for (int i = 0; i < 2; ++i) { int R, C; stage_rc(tid * 16 + i * 8192, R, C); const int Rb = Epi::PERM ? ((R & ~31) + perm32(R & 31)) : R;
        voffA[i] = (unsigned)(R * g.lda + C) * 2u; voffB[i] = (unsigned)(Rb * g.ldb + C) * 2u; }
    const size_t kstep = (size_t)(BK * 2);
    const size_t hsA = (size_t)HALF * g.lda * 2, hsB = (size_t)HALF * g.ldb * 2;
    const size_t tsA = 2 * hsA, tsB = 2 * hsB;
    const unsigned ldsw = (unsigned)wid * 1024u;
    const int aoff = lds_byte(wr * 64 + fr, fq * 8), boff = lds_byte(wc * 32 + fr, fq * 8);
#define PG8_SA(b, h) (((b) * 2 + (h)) * HTB)
#define PG8_SB(b, h) ((4 + (b) * 2 + (h)) * HTB)
#define PG8_STAGE(bufoff, gbase, voff) do { _Pragma("unroll") for (int _i = 0; _i < 2; ++_i) \
        __builtin_amdgcn_global_load_lds((const unsigned*)((const char*)(gbase) + (voff)[_i]), (PG8_LAS unsigned*)(lds + (bufoff) + ldsw + _i * 8192), 16, 0, 0); } while (0)
#define PG8_LDA(dst, b, h) do { _Pragma("unroll") for (int m = 0; m < 4; ++m) _Pragma("unroll") for (int k = 0; k < 2; ++k) dst[m][k] = *(const PG8_LAS bf16x8*)(lds + PG8_SA(b, h) + aoff + m * 2048 + k * 1024); } while (0)
#define PG8_LDB(dst, b, h) do { _Pragma("unroll") for (int n = 0; n < 2; ++n) _Pragma("unroll") for (int k = 0; k < 2; ++k) dst[n][k] = *(const PG8_LAS bf16x8*)(lds + PG8_SB(b, h) + boff + n * 2048 + k * 1024); } while (0)
#define PG8_MMA(ai, bj, At, Bt) do { __builtin_amdgcn_s_setprio(1); _Pragma("unroll") for (int m = 0; m < 4; ++m) _Pragma("unroll") for (int n = 0; n < 2; ++n) _Pragma("unroll") for (int k = 0; k < 2; ++k) \
        acc[ai][bj][m][n] = __builtin_amdgcn_mfma_f32_16x16x32_bf16(Bt[n][k], At[m][k], acc[ai][bj][m][n], 0, 0, 0); __builtin_amdgcn_s_setprio(0); } while (0)
#define PG8_WAIT_V(n) asm volatile("s_waitcnt vmcnt(" #n ")" ::: "memory")
#define PG8_WAIT_L(n) asm volatile("s_waitcnt lgkmcnt(" #n ")" ::: "memory")
#define PG8_BAR __builtin_amdgcn_s_barrier()
#define PG8_SCHED __builtin_amdgcn_sched_barrier(0)
    Unit cur, nxt; int ui = 0;
    if (!S.next(0, cur)) return;
    f32x4 acc[2][2][4][2];
#pragma unroll
    for (int a = 0; a < 2; ++a)
#pragma unroll
        for (int b = 0; b < 2; ++b)
#pragma unroll
            for (int m = 0; m < 4; ++m)
#pragma unroll
                for (int n = 0; n < 2; ++n) acc[a][b][m][n] = (f32x4){0.f, 0.f, 0.f, 0.f};
    bf16x8 At[4][2], B0[2][2], B1[2][2];
    const char* cA = (const char*)g.A + (size_t)cur.pm * tsA; const char* cB = (const char*)g.Bt + (size_t)cur.pn * tsB;
    S.a_ready(cur);
    if constexpr (SP2) {
        PG8_STAGE(PG8_SB(0, 0), cB, voffB); PG8_STAGE(PG8_SB(0, 1), cB + hsB, voffB); PG8_STAGE(PG8_SA(0, 0), cA, voffA); PG8_STAGE(PG8_SA(0, 1), cA + hsA, voffA);
        if (wr == 1) PG8_BAR;
        PG8_WAIT_V(2); PG8_BAR;
        PG8_STAGE(PG8_SB(1, 0), cB + kstep, voffB); PG8_STAGE(PG8_SA(1, 0), cA + kstep, voffA); PG8_STAGE(PG8_SB(1, 1), cB + hsB + kstep, voffB);
        PG8_WAIT_V(6); PG8_BAR;
    } else {
        PG8_STAGE(PG8_SB(0, 0), cB, voffB); PG8_STAGE(PG8_SA(0, 0), cA, voffA); PG8_STAGE(PG8_SB(0, 1), cB + hsB, voffB); PG8_STAGE(PG8_SA(0, 1), cA + hsA, voffA);
        if (wr == 1) PG8_BAR;
        PG8_WAIT_V(4); PG8_BAR;
        PG8_STAGE(PG8_SB(1, 0), cB + kstep, voffB); PG8_STAGE(PG8_SA(1, 0), cA + kstep, voffA); PG8_STAGE(PG8_SB(1, 1), cB + hsB + kstep, voffB);
        PG8_WAIT_V(6); PG8_BAR;
    }
    for (;;) {
        const bool has_next = S.next(ui + 1, nxt);
        const char* nA = has_next ? (const char*)g.A + (size_t)nxt.pm * tsA : cA; const char* nB = has_next ? (const char*)g.Bt + (size_t)nxt.pn * tsB : cB;
        for (int t = 0; t < nt; t += 2) {
            const bool last = (t == nt - 2);
            const char* a1 = cA + (size_t)(t + 1) * kstep;
            const char* a2 = last ? nA : cA + (size_t)(t + 2) * kstep; const char* b2 = last ? nB : cB + (size_t)(t + 2) * kstep;
            const char* a3 = a2 + kstep; const char* b3 = b2 + kstep;
            if (last && has_next) S.a_ready(nxt);
            if constexpr (SP2) {
            PG8_LDB(B0, 0, 0); PG8_LDB(B1, 0, 1); PG8_SCHED; PG8_LDA(At, 0, 0); PG8_STAGE(PG8_SA(1, 1), a1 + hsA, voffA);
            PG8_WAIT_V(8); PG8_WAIT_L(0); PG8_BAR; PG8_MMA(0, 0, At, B0); PG8_MMA(0, 1, At, B1); PG8_BAR; PG8_SCHED;
            PG8_LDA(At, 0, 1); PG8_STAGE(PG8_SB(0, 0), b2, voffB); PG8_STAGE(PG8_SB(0, 1), b2 + hsB, voffB); PG8_STAGE(PG8_SA(0, 0), a2, voffA);
            PG8_WAIT_V(8); PG8_WAIT_L(0); PG8_BAR; PG8_MMA(1, 0, At, B0); PG8_MMA(1, 1, At, B1); PG8_BAR; PG8_SCHED;
            PG8_LDB(B0, 1, 0); PG8_LDB(B1, 1, 1); PG8_SCHED; PG8_LDA(At, 1, 0); PG8_STAGE(PG8_SA(0, 1), a2 + hsA, voffA);
            PG8_WAIT_V(8); PG8_WAIT_L(0); PG8_BAR; PG8_MMA(0, 0, At, B0); PG8_MMA(0, 1, At, B1); PG8_BAR; PG8_SCHED;
            PG8_LDA(At, 1, 1); PG8_STAGE(PG8_SB(1, 0), b3, voffB); PG8_STAGE(PG8_SB(1, 1), b3 + hsB, voffB); PG8_STAGE(PG8_SA(1, 0), a3, voffA);
            PG8_WAIT_V(8); PG8_WAIT_L(0); PG8_BAR; PG8_MMA(1, 0, At, B0); PG8_MMA(1, 1, At, B1); PG8_BAR; PG8_SCHED;
            } else {
            PG8_LDB(B0, 0, 0); PG8_SCHED; PG8_LDA(At, 0, 0); PG8_STAGE(PG8_SA(1, 1), a1 + hsA, voffA);
            PG8_WAIT_L(8); PG8_BAR; PG8_WAIT_L(0); PG8_MMA(0, 0, At, B0); PG8_BAR; PG8_SCHED;
            PG8_LDB(B1, 0, 1); PG8_STAGE(PG8_SB(0, 0), b2, voffB);
            PG8_BAR; PG8_WAIT_L(0); PG8_MMA(0, 1, At, B1); PG8_BAR;
            PG8_LDA(At, 0, 1); PG8_STAGE(PG8_SA(0, 0), a2, voffA);
            PG8_BAR; PG8_WAIT_L(0); PG8_MMA(1, 0, At, B0); PG8_BAR; PG8_SCHED;
            PG8_STAGE(PG8_SB(0, 1), b2 + hsB, voffB);
            PG8_WAIT_V(6); PG8_BAR; PG8_MMA(1, 1, At, B1); PG8_BAR;
            PG8_LDB(B0, 1, 0); PG8_SCHED; PG8_LDA(At, 1, 0); PG8_STAGE(PG8_SA(0, 1), a2 + hsA, voffA);
            PG8_WAIT_L(8); PG8_BAR; PG8_WAIT_L(0); PG8_MMA(0, 0, At, B0); PG8_BAR; PG8_SCHED;
            PG8_LDB(B1, 1, 1); PG8_STAGE(PG8_SB(1, 0), b3, voffB);
            PG8_BAR; PG8_WAIT_L(0); PG8_MMA(0, 1, At, B1); PG8_BAR;
            PG8_LDA(At, 1, 1); PG8_STAGE(PG8_SA(1, 0), a3, voffA);
            PG8_BAR; PG8_WAIT_L(0); PG8_MMA(1, 0, At, B0); PG8_BAR; PG8_SCHED;
            PG8_STAGE(PG8_SB(1, 1), b3 + hsB, voffB);
            PG8_WAIT_V(6); PG8_BAR; PG8_MMA(1, 1, At, B1); PG8_BAR;
            }
        }
        if constexpr (ALIGN_EPI) { if (wr == 0) PG8_BAR; }
        if constexpr (!Epi::AFTER_DRAIN) { E(acc, cur, wr, wc, fr, fq); S.done(cur); }
        if (!has_next) break;
#pragma unroll
        for (int a = 0; a < 2; ++a)
#pragma unroll
            for (int b = 0; b < 2; ++b)
#pragma unroll
                for (int m = 0; m < 4; ++m)
#pragma unroll
                    for (int n = 0; n < 2; ++n) acc[a][b][m][n] = (f32x4){0.f, 0.f, 0.f, 0.f};
        cur = nxt; cA = nA; cB = nB; ++ui;
        if constexpr (ALIGN_EPI) { if (wr == 1) PG8_BAR; }
    }
    PG8_WAIT_V(0);
    if constexpr (!ALIGN_EPI) { if (wr == 0) PG8_BAR; }
    PG8_BAR;
    if constexpr (Epi::AFTER_DRAIN) { E.fused(acc, cur, wr, wc, fr, fq, lds, wid, lane); S.done(cur); }
#undef PG8_SA
#undef PG8_SB
#undef PG8_STAGE
#undef PG8_LDA
#undef PG8_LDB
#undef PG8_MMA
#undef PG8_WAIT_V
#undef PG8_WAIT_L
#undef PG8_BAR
#undef PG8_SCHED
}
}

#define LAS __attribute__((address_space(3)))
typedef unsigned short bf16_t;
typedef short bf16x8 __attribute__((ext_vector_type(8)));
typedef short s16x4 __attribute__((ext_vector_type(4)));
typedef float f32x4 __attribute__((ext_vector_type(4)));
typedef float f32x16 __attribute__((ext_vector_type(16)));
typedef unsigned u32x4 __attribute__((ext_vector_type(4)));
typedef unsigned u32x2 __attribute__((ext_vector_type(2)));
typedef float f32x2_t __attribute__((ext_vector_type(2)));
typedef __bf16 bf16x2_t __attribute__((ext_vector_type(2)));

constexpr int T = 16384, TC = 8192, DM = 1024, FF = 2816, KR = 17408;
constexpr int NTHR = 512, NWAVES = 8;
constexpr float EPS = 1e-6f;
constexpr size_t MiB = 1u << 20;
constexpr size_t WS_CTL = 0, CTL_BYTES = 4096;
constexpr size_t WS_MOD = 1 * MiB;
constexpr size_t WS_ROPE = 1 * MiB + 512 * 1024;
constexpr size_t WS_W1 = 2 * MiB, W1_BYTES = (size_t)5632 * 1024 * 2;
constexpr size_t WS_W2 = 46 * MiB, W2_BYTES = (size_t)1024 * 2816 * 2;
constexpr size_t WS_WIN = 68 * MiB, WIN_BYTES = (size_t)2048 * 1024 * 2;
constexpr size_t WS_WOUT = 76 * MiB, WOUT_BYTES = (size_t)1024 * 1024 * 2;
constexpr size_t WS_WQ = 80 * MiB, WQ_BYTES = (size_t)768 * 256 * 2;
constexpr size_t WS_WKV = WS_WQ + 2 * WQ_BYTES, WKV_BYTES = (size_t)768 * 256 * 2;
constexpr size_t WS_WGLU = WS_WKV + 2 * WKV_BYTES, WGLU_BYTES = (size_t)256 * 256 * 2;
constexpr size_t WS_BCAT = 82 * MiB, BCAT_BYTES = (size_t)16 * 256 * 512 * 2;
constexpr size_t WS_E = 90 * MiB, E_BYTES = (size_t)16 * 256 * 256 * 2;
constexpr size_t WS_XN = 94 * MiB;
constexpr size_t WS_H = 126 * MiB;
constexpr size_t WS_P = 126 * MiB;
constexpr size_t WS_Q2 = 126 * MiB;
constexpr size_t WS_KV = 150 * MiB;
constexpr size_t WS_QD = 190 * MiB;
constexpr size_t WS_KD = 214 * MiB;
constexpr size_t WS_VD = 227 * MiB;
constexpr size_t WS_CQN = 240 * MiB;
constexpr size_t WS_CKVN = 248 * MiB;
constexpr size_t WS_KPE = 257 * MiB;
constexpr size_t WS_A2 = 259 * MiB;
constexpr size_t WS_S = 275 * MiB;
constexpr size_t WS_END = 291 * MiB;
constexpr int CW_Q = 64;
constexpr int LDS_BYTES = 147456;
constexpr size_t OUT_DK = 16777216, OUT_DV = 23068672, OUT_CKV = 29360128, OUT_KPE = 31457280, OUT_SRE = 31981568, OUT_SIM = 32112640;

struct Args { const float* in[34]; float* out; unsigned char* ws; };
enum { I_XP = 0, I_XS, I_CDK, I_CDV, I_CCKV, I_CKPE, I_SRE, I_SIM, I_C, I_CCTX, I_WADA, I_BADA, I_NORMW, I_FFNIN, I_FFNOUT, I_WIN, I_DLAM, I_SUBLN, I_QNW, I_WQUP, I_KVNW, I_WKVUP,
       I_ARE, I_AIM, I_LSTEP, I_BRE, I_BIM, I_CRE, I_CIM, I_S5D, I_WGLU, I_BGLU, I_WOUT, I_FNW };

typedef volatile LAS unsigned long long* ArgTab;
__device__ __forceinline__ unsigned long long ldarg(ArgTab t, int i) { const unsigned long long v = t[i]; const unsigned lo = __builtin_amdgcn_readfirstlane((unsigned)v), hi = __builtin_amdgcn_readfirstlane((unsigned)(v >> 32)); return ((unsigned long long)hi << 32) | lo; }
__device__ __forceinline__ Args load_args(ArgTab t) { Args b;
#pragma unroll
    for (int i = 0; i < 34; ++i) b.in[i] = (const float*)ldarg(t, i);
    b.out = (float*)ldarg(t, 34); b.ws = (unsigned char*)ldarg(t, 35); return b; }
#define LDS_WAIT() asm volatile("s_waitcnt lgkmcnt(0)" ::: "memory")
__device__ __forceinline__ unsigned cvtpk(float lo, float hi) { f32x2_t v = {lo, hi}; bf16x2_t b = __builtin_convertvector(v, bf16x2_t); return __builtin_bit_cast(unsigned, b); }
__device__ __forceinline__ float bflo(unsigned w) { return __uint_as_float(w << 16); }
__device__ __forceinline__ float bfhi(unsigned w) { return __uint_as_float(w & 0xffff0000u); }
__device__ __forceinline__ float shx(float v, int o, int lane) { return __builtin_bit_cast(float, __builtin_amdgcn_ds_bpermute((lane ^ o) << 2, __builtin_bit_cast(int, v))); }
__device__ __forceinline__ float wave_sum(float v, int lane) {
#pragma unroll
    for (int o = 1; o < 64; o <<= 1) v += shx(v, o, lane);
    return v;
}
__device__ __forceinline__ void sincos_rev(float ang, float& s, float& c) {
    float rev = ang * 0.15915494309189535f; rev -= floorf(rev);
    s = __builtin_amdgcn_sinf(rev); c = __builtin_amdgcn_cosf(rev);
}
__device__ __forceinline__ void unpack8(const u32x4 r, float (&v)[8]) {
    v[0] = bflo(r.x); v[1] = bfhi(r.x); v[2] = bflo(r.y); v[3] = bfhi(r.y); v[4] = bflo(r.z); v[5] = bfhi(r.z); v[6] = bflo(r.w); v[7] = bfhi(r.w);
}
__device__ __forceinline__ u32x4 pack8(const float (&v)[8]) { u32x4 w; w.x = cvtpk(v[0], v[1]); w.y = cvtpk(v[2], v[3]); w.z = cvtpk(v[4], v[5]); w.w = cvtpk(v[6], v[7]); return w; }

__device__ __forceinline__ void transpose_item(const float* W, int ldw, int k0, int nsrc0, bf16_t* WT, int ldt, int ndst0, LAS float* scr, int lane) {
#pragma unroll 8
    for (int i = 0; i < 32; ++i) { const int kk = 2 * i + (lane >> 5); scr[kk * 33 + (lane & 31)] = W[(size_t)(k0 + kk) * ldw + nsrc0 + (lane & 31)]; }
    LDS_WAIT(); asm volatile("" ::: "memory");
    const int c = lane & 7;
#pragma unroll
    for (int j = 0; j < 4; ++j) { const int n = (lane >> 3) + 8 * j; const LAS float* s = scr + (8 * c) * 33 + n;
        u32x4 o; o.x = cvtpk(s[0 * 33], s[1 * 33]); o.y = cvtpk(s[2 * 33], s[3 * 33]); o.z = cvtpk(s[4 * 33], s[5 * 33]); o.w = cvtpk(s[6 * 33], s[7 * 33]);
        *(u32x4*)(WT + (size_t)(ndst0 + n) * ldt + k0 + 8 * c) = o; }
    LDS_WAIT(); asm volatile("" ::: "memory");
}
__device__ __forceinline__ void convert_weights(const Args& a, LAS unsigned char* lds, int gw, int ngw, int wave, int lane) {
    LAS float* scr = (LAS float*)(lds + wave * 16384);
    unsigned char* ws = a.ws;
    constexpr int I_1 = 16 * 176, I_2 = 44 * 32, I_IN = 16 * 57, I_O = 16 * 32, I_Q = 4 * 18, I_KV = 2 * 24, I_G = 4 * 8;
    constexpr int NITEMS = 4 * I_1 + 4 * I_2 + 2 * I_IN + 2 * I_O + 2 * I_Q + 2 * I_KV + 2 * I_G;
    for (int it = gw; it < NITEMS; it += ngw) {
        int r = it;
        if (r < 4 * I_1) { const int mi = r / I_1, q = r % I_1, kb = q / 176, nb = q % 176, nd = nb * 32;
            const int ns = ((nd >> 7) & 1) * 2816 + (nd >> 8) * 128 + (nd & 127);
            transpose_item(a.in[I_FFNIN] + (size_t)mi * 1024 * 5632, 5632, kb * 64, ns, (bf16_t*)(ws + WS_W1 + mi * W1_BYTES), 1024, nd, scr, lane); continue; }
        r -= 4 * I_1;
        if (r < 4 * I_2) { const int mi = r / I_2, q = r % I_2, kb = q / 32, nb = q % 32;
            transpose_item(a.in[I_FFNOUT] + (size_t)mi * 2816 * 1024, 1024, kb * 64, nb * 32, (bf16_t*)(ws + WS_W2 + mi * W2_BYTES), 2816, nb * 32, scr, lane); continue; }
        r -= 4 * I_2;
        if (r < 2 * I_IN) { const int mi = r / I_IN, q = r % I_IN, kb = q / 57, nb = q % 57;
            transpose_item(a.in[I_WIN] + (size_t)mi * 1024 * 1824, 1824, kb * 64, nb * 32, (bf16_t*)(ws + WS_WIN + mi * WIN_BYTES), 1024, nb * 32, scr, lane); continue; }
        r -= 2 * I_IN;
        if (r < 2 * I_O) { const int mi = r / I_O, q = r % I_O, kb = q / 32, nb = q % 32;
            transpose_item(a.in[I_WOUT] + (size_t)mi * 1024 * 1024, 1024, kb * 64, nb * 32, (bf16_t*)(ws + WS_WOUT + mi * WOUT_BYTES), 1024, nb * 32, scr, lane); continue; }
        r -= 2 * I_O;
        if (r < 2 * I_Q) { const int mi = r / I_Q, q = r % I_Q, kb = q / 18, nb = q % 18;
            transpose_item(a.in[I_WQUP] + (size_t)mi * 256 * 576, 576, kb * 64, nb * 32, (bf16_t*)(ws + WS_WQ + mi * WQ_BYTES), 256, nb * 32, scr, lane); continue; }
        r -= 2 * I_Q;
        if (r < 2 * I_KV) { const int mi = r / I_KV, q = r % I_KV, kb = q / 24, nb = q % 24;
            bf16_t* dst = (bf16_t*)(ws + WS_WKV + mi * WKV_BYTES);
            transpose_item(a.in[I_WKVUP] + (size_t)mi * 128 * 768, 768, kb * 64, nb * 32, dst, 256, nb * 32, scr, lane);
            { const int n = lane >> 1, half = lane & 1; unsigned z0 = 0u; asm volatile("" : "+v"(z0)); const u32x4 z = {z0, z0, z0, z0};
#pragma unroll
              for (int j = 0; j < 4; ++j) *(u32x4*)(dst + (size_t)(nb * 32 + n) * 256 + 128 + kb * 64 + half * 32 + j * 8) = z; }
            continue; }
        r -= 2 * I_KV;
        { const int mi = r / I_G, q = r % I_G, kb = q / 8, nb = q % 8;
            transpose_item(a.in[I_WGLU] + (size_t)mi * 256 * 256, 256, kb * 64, nb * 32, (bf16_t*)(ws + WS_WGLU + mi * WGLU_BYTES), 256, nb * 32, scr, lane); }
    }
}
__device__ __forceinline__ void adaln_item(const Args& a, LAS unsigned char* lds, int item, int tid) {
    LAS float* sc = (LAS float*)lds;
    LAS float* red = (LAS float*)(lds + 20480);
    const int l = item / 72, chunk = item % 72;
    for (int i = tid; i < 5 * 1024; i += NTHR) { const int cd = i >> 10, k = i & 1023; const float v = cd == 0 ? a.in[I_CCTX][k] : a.in[I_C][(cd - 1) * 1024 + k]; sc[i] = v * __builtin_amdgcn_rcpf(1.0f + __expf(-v)); }
    __syncthreads();
    const int cg4 = tid & 31, kg = tid >> 5;
    const float* wp = a.in[I_WADA] + ((size_t)l * 1024 + kg * 64) * 9216 + chunk * 128 + 4 * cg4;
    f32x4 acc[5];
#pragma unroll
    for (int c = 0; c < 5; ++c) acc[c] = (f32x4){0.f, 0.f, 0.f, 0.f};
#pragma unroll 4
    for (int k = 0; k < 64; ++k) { const f32x4 w = *(const f32x4*)(wp + (size_t)k * 9216);
#pragma unroll
        for (int c = 0; c < 5; ++c) acc[c] += w * sc[c * 1024 + kg * 64 + k]; }
#pragma unroll
    for (int c = 0; c < 5; ++c) *(LAS f32x4*)(red + (kg * 5 + c) * 128 + 4 * cg4) = acc[c];
    __syncthreads();
    for (int o = tid; o < 640; o += NTHR) { const int c = o >> 7, col = o & 127; float s = 0.f;
#pragma unroll
        for (int k = 0; k < 16; ++k) s += red[(k * 5 + c) * 128 + col];
        const int gc = chunk * 128 + col;
        ((float*)(a.ws + WS_MOD))[((size_t)l * 5 + c) * 9216 + gc] = s + a.in[I_BADA][(size_t)l * 9216 + gc]; }
    __syncthreads();
}
__device__ __forceinline__ void s5gen_item(const Args& a, LAS unsigned char* lds, int item, int tid) {
    const int l = item >> 4, g = item & 15;
    LAS float* pwr = (LAS float*)lds;
    LAS float* pwi = pwr + 2 * 64 * 17;
    LAS float* bbr = pwi + 2 * 64 * 17;
    LAS float* bbi = bbr + 2 * 64 * 16;
    LAS float* cr = bbi + 2 * 64 * 16;
    LAS float* ci = cr + 2 * 16 * 64;
    LAS float* klag = ci + 2 * 16 * 64;
    if (tid < 128) { const int d = tid >> 6, p = tid & 63; const size_t ix = (((size_t)l * 2 + d) * 16 + g) * 64 + p;
        const float are = a.in[I_ARE][ix], aim = a.in[I_AIM][ix], st = __expf(a.in[I_LSTEP][((size_t)l * 2 + d) * 16 + g]);
        float l1r = 0.f, l1i = 0.f;
        for (int k = 0; k <= 16; ++k) { const float mag = __expf((float)k * are * st); float s, c; sincos_rev((float)k * aim * st, s, c);
            pwr[(d * 64 + p) * 17 + k] = mag * c; pwi[(d * 64 + p) * 17 + k] = mag * s; if (k == 1) { l1r = mag * c; l1i = mag * s; } }
        const float xr = l1r - 1.0f, xi = l1i, den = 1.0f / (are * are + aim * aim);
        const float cfr = (xr * are + xi * aim) * den, cfi = (xi * are - xr * aim) * den;
        for (int c = 0; c < 16; ++c) { const float br = a.in[I_BRE][ix * 16 + c], bi = a.in[I_BIM][ix * 16 + c];
            bbr[(d * 64 + p) * 16 + c] = cfr * br - cfi * bi; bbi[(d * 64 + p) * 16 + c] = cfr * bi + cfi * br; }
    }
    for (int i = tid; i < 2048; i += NTHR) { const int d = i >> 10, co = (i >> 6) & 15, p = i & 63; const size_t ix = ((((size_t)l * 2 + d) * 16 + g) * 16 + co) * 64 + p;
        cr[i] = a.in[I_CRE][ix]; ci[i] = a.in[I_CIM][ix]; }
    __syncthreads();
    for (int i = tid; i < 8192; i += NTHR) { const int d = i >> 12, j = (i >> 8) & 15, co = (i >> 4) & 15, cin = i & 15; float s = 0.f;
        for (int p = 0; p < 64; ++p) { const float c_r = cr[(d * 16 + co) * 64 + p], c_i = ci[(d * 16 + co) * 64 + p], p_r = pwr[(d * 64 + p) * 17 + j], p_i = pwi[(d * 64 + p) * 17 + j];
            const float gr = c_r * p_r - c_i * p_i, gi = c_r * p_i + c_i * p_r; s += gr * bbr[(d * 64 + p) * 16 + cin] - gi * bbi[(d * 64 + p) * 16 + cin]; }
        klag[i] = s; }
    __syncthreads();
    bf16_t* Bc = (bf16_t*)(a.ws + WS_BCAT + (size_t)l * BCAT_BYTES) + (size_t)g * 256 * 512;
    bf16_t* Em = (bf16_t*)(a.ws + WS_E + (size_t)l * E_BYTES) + (size_t)g * 256 * 256;
    const float* Dv = a.in[I_S5D] + ((size_t)l * 16 + g) * 16;
    for (int i = tid; i < 256 * 256; i += NTHR) { const int n = i >> 8, k2 = (i & 255) * 2; const int t = n >> 4, co = n & 15; float v[2];
#pragma unroll
        for (int e = 0; e < 2; ++e) { const int k = k2 + e;
            if (k < 256) { const int s = k >> 4, cin = k & 15; float x = 0.f;
                if (s <= t) x += klag[((0 * 16 + (t - s)) * 16 + co) * 16 + cin];
                if (s >= t) x += klag[((1 * 16 + (s - t)) * 16 + co) * 16 + cin];
                if (s == t && cin == co) x += Dv[co];
                v[e] = x; }
            else { const int kk = k - 256, d = kk >> 7, p = (kk >> 1) & 63, ri = kk & 1, pe = d == 0 ? t + 1 : 16 - t;
                const float c_r = cr[(d * 16 + co) * 64 + p], c_i = ci[(d * 16 + co) * 64 + p], p_r = pwr[(d * 64 + p) * 17 + pe], p_i = pwi[(d * 64 + p) * 17 + pe];
                v[e] = ri == 0 ? (c_r * p_r - c_i * p_i) : -(c_r * p_i + c_i * p_r); } }
        *(unsigned*)(Bc + (size_t)n * 512 + k2) = cvtpk(v[0], v[1]); }
    for (int i = tid; i < 256 * 128; i += NTHR) { const int n = i >> 7, k2 = (i & 127) * 2; const int d = n >> 7, p = (n >> 1) & 63, ri = n & 1; float v[2];
#pragma unroll
        for (int e = 0; e < 2; ++e) { const int k = k2 + e, s = k >> 4, cin = k & 15, pe = d == 0 ? 15 - s : s;
            const float p_r = pwr[(d * 64 + p) * 17 + pe], p_i = pwi[(d * 64 + p) * 17 + pe], b_r = bbr[(d * 64 + p) * 16 + cin], b_i = bbi[(d * 64 + p) * 16 + cin];
            v[e] = ri == 0 ? (p_r * b_r - p_i * b_i) : (p_r * b_i + p_i * b_r); }
        *(unsigned*)(Em + (size_t)n * 256 + k2) = cvtpk(v[0], v[1]); }
    __syncthreads();
}
__device__ __forceinline__ void phase0(const Args& a, LAS unsigned char* lds, int tid, int wave, int lane) {
    const int b = blockIdx.x, G = gridDim.x;
    for (int it = b; it < 144; it += G) adaln_item(a, lds, it, tid);
    for (int it = (b + G - 144 % G) % G; it < 32; it += G) s5gen_item(a, lds, it, tid);
    if (b == G - 1) { const int pos = tid >> 3, i = tid & 7; const float inv = exp2f(-(float)i * 0.125f * 13.287712379549449f); float s, c; sincos_rev((float)pos * inv, s, c);
        float* rt = (float*)(a.ws + WS_ROPE); rt[(pos * 8 + i) * 2 + 0] = c; rt[(pos * 8 + i) * 2 + 1] = s; }
    __syncthreads();
    convert_weights(a, lds, b * NWAVES + wave, G * NWAVES, wave, lane);
}

__device__ __forceinline__ const float* xrow_ptr(const Args& a, int l, int m) {
    if (l == 0) return m < TC ? a.in[I_XP] + (size_t)m * DM : a.in[I_XS] + (size_t)(m - TC) * DM;
    return a.out + (size_t)m * DM;
}
__device__ __forceinline__ void norm_phase(const Args& a, int l, int j, bool src_inputs, int gw, int ngw, int lane) {
    const float* nw = a.in[I_NORMW] + ((size_t)l * 3 + j) * DM;
    bf16_t* XN = (bf16_t*)(a.ws + WS_XN);
    for (int m = gw; m < T; m += ngw) {
        const float* xr = src_inputs ? xrow_ptr(a, 0, m) : a.out + (size_t)m * DM;
        const int cond = m < TC ? 0 : 1 + ((m - TC) >> 11);
        const float* md = (const float*)(a.ws + WS_MOD) + ((size_t)l * 5 + cond) * 9216 + (size_t)(3 * j) * DM;
        f32x4 v[4]; float ss = 0.f;
#pragma unroll
        for (int q = 0; q < 4; ++q) { v[q] = ((const f32x4*)xr)[lane + 64 * q]; ss += (v[q].x * v[q].x + v[q].y * v[q].y) + (v[q].z * v[q].z + v[q].w * v[q].w); }
        const float rinv = __builtin_amdgcn_rsqf(wave_sum(ss, lane) * (1.0f / DM) + EPS);
#pragma unroll
        for (int q = 0; q < 4; ++q) { const int ix = lane + 64 * q; const f32x4 w = ((const f32x4*)nw)[ix], sh = ((const f32x4*)md)[ix], sc = ((const f32x4*)(md + DM))[ix];
            const f32x4 y = v[q] * rinv * w * (sc + 1.0f) + sh;
            u32x2 o; o.x = cvtpk(y.x, y.y); o.y = cvtpk(y.z, y.w); ((u32x2*)(XN + (size_t)m * DM))[ix] = o; }
    }
}
__device__ __forceinline__ void final_norm_phase(const Args& a, int gw, int ngw, int lane) {
    const float* nw = a.in[I_FNW];
    for (int m = gw; m < T; m += ngw) { float* xr = a.out + (size_t)m * DM; f32x4 v[4]; float ss = 0.f;
#pragma unroll
        for (int q = 0; q < 4; ++q) { v[q] = ((const f32x4*)xr)[lane + 64 * q]; ss += (v[q].x * v[q].x + v[q].y * v[q].y) + (v[q].z * v[q].z + v[q].w * v[q].w); }
        const float rinv = __builtin_amdgcn_rsqf(wave_sum(ss, lane) * (1.0f / DM) + EPS);
#pragma unroll
        for (int q = 0; q < 4; ++q) { const int ix = lane + 64 * q; ((f32x4*)xr)[ix] = v[q] * rinv * ((const f32x4*)nw)[ix]; } }
}

__device__ __forceinline__ void post_phase(const Args& a, int l, int gw, int ngw, int lane) {
    unsigned char* ws = a.ws;
    const bf16_t* P = (const bf16_t*)(ws + WS_P);
    bf16_t* QD = (bf16_t*)(ws + WS_QD); bf16_t* KD = (bf16_t*)(ws + WS_KD); bf16_t* VD = (bf16_t*)(ws + WS_VD);
    bf16_t* CQN = (bf16_t*)(ws + WS_CQN); bf16_t* CKVN = (bf16_t*)(ws + WS_CKVN); bf16_t* KPE = (bf16_t*)(ws + WS_KPE); bf16_t* A2 = (bf16_t*)(ws + WS_A2);
    const float* rope = (const float*)(ws + WS_ROPE);
    const float* qnw = a.in[I_QNW] + (size_t)l * 256; const float* kvnw = a.in[I_KVNW] + (size_t)l * 128;
    const float QS = 0.17677669529663687f * 1.4426950408889634f;
    for (int m = gw; m < T + 1024; m += ngw) {
        if (m >= T) {
            const int r = m - T, b = r >> 8, s = r & 255; const size_t kr = 8192 + (size_t)b * 2304 + 2048 + s;
            const size_t src = ((size_t)(b * 2 + l) * 256 + s);
            const float* ck = a.in[I_CDK] + src * 384; const float* cv = a.in[I_CDV] + src * 384;
#pragma unroll
            for (int q = 0; q < 3; ++q) { const int j = 2 * (lane + 64 * q);
                *(unsigned*)(KD + kr * 384 + j) = cvtpk(ck[j], ck[j + 1]); *(unsigned*)(VD + kr * 384 + j) = cvtpk(cv[j], cv[j + 1]); }
            const float* cc = a.in[I_CCKV] + src * 128; *(unsigned*)(CKVN + kr * 256 + 2 * lane) = cvtpk(cc[2 * lane], cc[2 * lane + 1]); *(unsigned*)(CKVN + kr * 256 + 128 + 2 * lane) = 0u;
            if (lane < 16) { const float* cp = a.in[I_CKPE] + src * 32; *(unsigned*)(KPE + kr * 32 + 2 * lane) = cvtpk(cp[2 * lane], cp[2 * lane + 1]); }
            continue;
        }
        const bool lat = m >= TC;
        int b = 0, t = 0; if (lat) { b = (m - TC) >> 11; t = (m - TC) & 2047; }
        const size_t kr = lat ? 8192 + (size_t)b * 2304 + t : (size_t)m;
        const int prow = t >> 6, pcol = t & 63;
        const size_t orow = ((size_t)((m >> 8) * 2 + l) * 256 + (m & 255));
        const u32x4* pr = (const u32x4*)(P + (size_t)m * 2048);
#pragma unroll
        for (int i = 0; i < 4; ++i) {
            const int c = lane + 64 * i;
            const u32x4 raw = pr[c];
            float v[8], pv[8]; unpack8(raw, v);
#pragma unroll
            for (int e = 0; e < 8; ++e) pv[e] = shx(v[e], 1, lane);
            float rv[8];
            { const int pos = (c & 2) ? pcol : prow; const f32x4* rp = (const f32x4*)(rope + pos * 16);
#pragma unroll
              for (int e2 = 0; e2 < 4; ++e2) { f32x4 cs = rp[e2];
                  if (!lat) cs = (f32x4){1.0f, 0.0f, 1.0f, 0.0f};
                  if (c & 1) { rv[2 * e2] = pv[2 * e2] * cs.y + v[2 * e2] * cs.x; rv[2 * e2 + 1] = pv[2 * e2 + 1] * cs.w + v[2 * e2 + 1] * cs.z; }
                  else       { rv[2 * e2] = v[2 * e2] * cs.x - pv[2 * e2] * cs.y; rv[2 * e2 + 1] = v[2 * e2 + 1] * cs.z - pv[2 * e2 + 1] * cs.w; } } }
            float ssq = 0.f, sskv = 0.f;
            if (i == 2) { float s = 0.f;
#pragma unroll
                for (int e = 0; e < 8; ++e) s += v[e] * v[e];
                ssq = wave_sum((lane >= 16 && lane < 48) ? s : 0.f, lane); sskv = wave_sum(lane >= 48 ? s : 0.f, lane); }
            if (c < 48) {
                float o[8];
#pragma unroll
                for (int e = 0; e < 8; ++e) o[e] = rv[e] * QS;
                *(u32x4*)(QD + (size_t)m * 384 + 8 * c) = pack8(o);
            } else if (c < 96) {
                const int cs = c - 48;
                *(u32x4*)(KD + kr * 384 + 8 * cs) = pack8(rv);
                if (!lat) { float* o = a.out + OUT_DK + orow * 384 + 8 * cs;
                       *(f32x4*)o = (f32x4){v[0], v[1], v[2], v[3]}; *(f32x4*)(o + 4) = (f32x4){v[4], v[5], v[6], v[7]}; }
            } else if (c < 144) {
                const int cs = c - 96;
                *(u32x4*)(VD + kr * 384 + 8 * cs) = raw;
                if (!lat) { float* o = a.out + OUT_DV + orow * 384 + 8 * cs; *(f32x4*)o = (f32x4){v[0], v[1], v[2], v[3]}; *(f32x4*)(o + 4) = (f32x4){v[4], v[5], v[6], v[7]}; }
            } else if (c < 176) {
                const int cs = c - 144; const float rinv = __builtin_amdgcn_rsqf(ssq * (1.0f / 256.0f) + EPS); float o[8];
#pragma unroll
                for (int e = 0; e < 8; ++e) o[e] = v[e] * rinv * qnw[8 * cs + e];
                *(u32x4*)(CQN + (size_t)m * 256 + 8 * cs) = pack8(o);
            } else if (c < 192) {
                const int cs = c - 176; const float rinv = __builtin_amdgcn_rsqf(sskv * (1.0f / 128.0f) + EPS); float o[8];
#pragma unroll
                for (int e = 0; e < 8; ++e) o[e] = v[e] * rinv * kvnw[8 * cs + e];
                *(u32x4*)(CKVN + kr * 256 + 8 * cs) = pack8(o); { unsigned z = 0u; asm volatile("" : "+v"(z)); *(u32x4*)(CKVN + kr * 256 + 128 + 8 * cs) = (u32x4){z, z, z, z}; }
                if (!lat) { float* op = a.out + OUT_CKV + orow * 128 + 8 * cs; *(f32x4*)op = (f32x4){o[0], o[1], o[2], o[3]}; *(f32x4*)(op + 4) = (f32x4){o[4], o[5], o[6], o[7]}; }
            } else if (c < 196) {
                const int cs = c - 192;
                *(u32x4*)(KPE + kr * 32 + 8 * cs) = pack8(rv);
                if (!lat) { float* op = a.out + OUT_KPE + orow * 32 + 8 * cs;
                       *(f32x4*)op = (f32x4){v[0], v[1], v[2], v[3]}; *(f32x4*)(op + 4) = (f32x4){v[4], v[5], v[6], v[7]}; }
            } else if (c < 228) {
                const int cs = c - 196, g = cs >> 1;
                *(u32x4*)(A2 + ((size_t)g * 1024 + (m >> 4)) * 512 + (m & 15) * 16 + (cs & 1) * 8) = raw;
            }
        }
    }
}

__device__ __forceinline__ void s5_combine_phase(const Args& a, int l, int gw, int ngw, int lane) {
    const float* S = (const float*)(a.ws + WS_S); bf16_t* A2 = (bf16_t*)(a.ws + WS_A2);
    for (int w = gw; w < 36 * 32; w += ngw) {
        const int seq = w >> 5, g = (w >> 1) & 15, d = w & 1, p = lane;
        const size_t ix = (((size_t)l * 2 + d) * 16 + g) * 64 + p;
        const float are = a.in[I_ARE][ix], aim = a.in[I_AIM][ix], st = __expf(a.in[I_LSTEP][((size_t)l * 2 + d) * 16 + g]);
        const float mag = __expf(16.0f * are * st); float sn, cs; sincos_rev(16.0f * aim * st, sn, cs);
        const float lr = mag * cs, li = mag * sn;
        const bool lat = seq >= 32; const int nch = lat ? 128 : 16; const int row0 = lat ? 512 + (seq - 32) * 128 : seq * 16;
        float hr = 0.f, hi = 0.f;
        if (lat) { const size_t six = ((((size_t)(seq - 32) * 2 + l) * 2 + d) * 16 + g) * 64 + p; hr = a.in[I_SRE][six]; hi = a.in[I_SIM][six]; }
        for (int cc = 0; cc < nch; ++cc) { const int ch = d == 0 ? cc : nch - 1 - cc; const size_t row = (size_t)g * 1024 + row0 + ch;
            *(unsigned*)(A2 + row * 512 + 256 + d * 128 + 2 * p) = cvtpk(hr, hi);
            const f32x2_t s = *(const f32x2_t*)(S + row * 256 + d * 128 + 2 * p);
            const float nr = lr * hr - li * hi + s.x, ni = lr * hi + li * hr + s.y; hr = nr; hi = ni; }
        if (!lat) { const size_t oix = ((((size_t)seq * 2 + l) * 2 + d) * 16 + g) * 64 + p; a.out[OUT_SRE + oix] = hr; a.out[OUT_SIM + oix] = hi; }
    }
}

struct AttnState { float m, l; f32x16 o[2]; };
__device__ __forceinline__ bf16x8 vfrag(const LAS bf16_t* vb) {
    typedef short v4i16_t __attribute__((ext_vector_type(4)));
    const s16x4 lo = __builtin_bit_cast(s16x4, __builtin_amdgcn_ds_read_tr16_b64_v4i16((LAS v4i16_t*)vb));
    const s16x4 hi = __builtin_bit_cast(s16x4, __builtin_amdgcn_ds_read_tr16_b64_v4i16((LAS v4i16_t*)(vb + 256)));
    return (bf16x8){lo[0], lo[1], lo[2], lo[3], hi[0], hi[1], hi[2], hi[3]};
}
template <int NK>
__device__ __forceinline__ void attn_tile(AttnState& st, const LAS bf16_t* Kl, int kstr, int koff, const bf16x8* qf, const LAS bf16_t* vrd, int lane) {
    const int r32 = lane & 31, hi = lane >> 5;
    f32x16 s0, s1;
#pragma unroll
    for (int e = 0; e < 16; ++e) { s0[e] = 0.f; s1[e] = 0.f; }
    const LAS bf16_t* kp = Kl + r32 * kstr + koff + 8 * hi;
#pragma unroll
    for (int ks = 0; ks < NK; ++ks) {
        const bf16x8 k0 = *(const LAS bf16x8*)(kp + 16 * ks), k1 = *(const LAS bf16x8*)(kp + 32 * kstr + 16 * ks);
        s0 = __builtin_amdgcn_mfma_f32_32x32x16_bf16(k0, qf[ks], s0, 0, 0, 0);
        s1 = __builtin_amdgcn_mfma_f32_32x32x16_bf16(k1, qf[ks], s1, 0, 0, 0);
    }
    float mx = s0[0];
#pragma unroll
    for (int e = 1; e < 16; ++e) mx = fmaxf(mx, s0[e]);
#pragma unroll
    for (int e = 0; e < 16; ++e) mx = fmaxf(mx, s1[e]);
    mx = fmaxf(mx, shx(mx, 32, lane));
    const float mnew = fmaxf(st.m, mx), alpha = __builtin_amdgcn_exp2f(st.m - mnew); st.m = mnew;
    float rs = 0.f;
#pragma unroll
    for (int e = 0; e < 16; ++e) { s0[e] = __builtin_amdgcn_exp2f(s0[e] - mnew); s1[e] = __builtin_amdgcn_exp2f(s1[e] - mnew); rs += s0[e] + s1[e]; }
    st.l = st.l * alpha + rs;
#pragma unroll
    for (int e = 0; e < 16; ++e) { st.o[0][e] *= alpha; st.o[1][e] *= alpha; }
    bf16x8 pb[2][2];
#pragma unroll
    for (int s = 0; s < 2; ++s) {
        u32x4 w0; w0.x = cvtpk(s0[8 * s + 0], s0[8 * s + 1]); w0.y = cvtpk(s0[8 * s + 2], s0[8 * s + 3]); w0.z = cvtpk(s0[8 * s + 4], s0[8 * s + 5]); w0.w = cvtpk(s0[8 * s + 6], s0[8 * s + 7]);
        u32x4 w1; w1.x = cvtpk(s1[8 * s + 0], s1[8 * s + 1]); w1.y = cvtpk(s1[8 * s + 2], s1[8 * s + 3]); w1.z = cvtpk(s1[8 * s + 4], s1[8 * s + 5]); w1.w = cvtpk(s1[8 * s + 6], s1[8 * s + 7]);
        pb[0][s] = __builtin_bit_cast(bf16x8, w0); pb[1][s] = __builtin_bit_cast(bf16x8, w1);
    }
#pragma unroll
    for (int db = 0; db < 2; ++db)
#pragma unroll
        for (int kb = 0; kb < 2; ++kb)
#pragma unroll
            for (int s = 0; s < 2; ++s) st.o[db] = __builtin_amdgcn_mfma_f32_32x32x16_bf16(vfrag(vrd + db * 2048 + (32 * kb + 16 * s) * 32), pb[kb][s], st.o[db], 0, 0, 0);
}
template <int MODE>
__device__ __forceinline__ void attn_item(const Args& a, LAS unsigned char* lds, int l, int ksp, int h, int qt, float lam, float lam_init, int tid, int wave, int lane) {
    constexpr int KSTR = MODE == 0 ? 72 : 104;
    unsigned char* ws = a.ws;
    LAS bf16_t* Kl = (LAS bf16_t*)lds; LAS bf16_t* Vl = (LAS bf16_t*)(lds + 13312);
    const bool lat = ksp >= 32;
    const int nt = lat ? 36 : 4;
    const size_t keyrow0 = lat ? 8192 + (size_t)(ksp - 32) * 2304 : (size_t)ksp * 256;
    const int qrow0 = lat ? TC + (ksp - 32) * 2048 + qt * 256 : ksp * 256;
    const int r32 = lane & 31, hi = lane >> 5;
    const int qrow = qrow0 + 32 * wave + r32;
    const bf16_t* Ksrc; const bf16_t* Vsrc; const bf16_t* Psrc = nullptr; int kvs;
    if (MODE == 0) { Ksrc = (const bf16_t*)(ws + WS_KD) + keyrow0 * 384 + h * 64; Vsrc = (const bf16_t*)(ws + WS_VD) + keyrow0 * 384 + h * 64; kvs = 384; }
    else { Ksrc = (const bf16_t*)(ws + WS_KV) + keyrow0 * 768 + h * 128; Vsrc = Ksrc + 64; Psrc = (const bf16_t*)(ws + WS_KPE) + keyrow0 * 32; kvs = 768; }
    constexpr int NQF = MODE == 0 ? 4 : 6;
    bf16x8 qf[NQF];
    if (MODE == 0) { const bf16_t* qp = (const bf16_t*)(ws + WS_QD) + (size_t)qrow * 384 + h * 64 + 8 * hi;
#pragma unroll
        for (int f = 0; f < 4; ++f) qf[f] = *(const bf16x8*)(qp + 16 * f); }
    else { const float QS1 = 0.10206207261596577f * 1.4426950408889634f;
        const bf16_t* qp = (const bf16_t*)(ws + WS_Q2) + (size_t)qrow * 768 + h * 96;
        const int t = (qrow - TC) & 2047; const float* rope = (const float*)(ws + WS_ROPE);
#pragma unroll
        for (int f = 0; f < 6; ++f) { float o[8];
            if (f < 4) { float v[8]; unpack8(*(const u32x4*)(qp + 16 * f + 8 * hi), v);
#pragma unroll
                for (int e = 0; e < 8; ++e) o[e] = v[e] * QS1; }
            else { float x1[8], x2[8]; unpack8(*(const u32x4*)(qp + 16 * f), x1); unpack8(*(const u32x4*)(qp + 16 * f + 8), x2);
                const int pos = f == 4 ? (t >> 6) : (t & 63); const float* rp = rope + pos * 16;
#pragma unroll
                for (int e = 0; e < 8; ++e) { const float cs = lat ? rp[2 * e] : 1.0f, sn = lat ? rp[2 * e + 1] : 0.0f;
                    o[e] = (hi == 0 ? x1[e] * cs - x2[e] * sn : x1[e] * sn + x2[e] * cs) * QS1; } }
            qf[f] = __builtin_bit_cast(bf16x8, pack8(o)); } }
    AttnState st0, st1;
    st0.m = -1e30f; st0.l = 0.f; st1.m = -1e30f; st1.l = 0.f;
#pragma unroll
    for (int e = 0; e < 16; ++e) { st0.o[0][e] = 0.f; st0.o[1][e] = 0.f; st1.o[0][e] = 0.f; st1.o[1][e] = 0.f; }
    const int key = tid >> 3, ch = tid & 7;
    const bf16_t* kg = Ksrc + (size_t)key * kvs + 8 * ch; const bf16_t* vg = Vsrc + (size_t)key * kvs + 8 * ch;
    const bf16_t* pg = MODE == 1 ? Psrc + (size_t)(tid >> 2) * 32 + 8 * (tid & 3) : nullptr;
    LAS bf16_t* kl = Kl + key * KSTR + 8 * ch; LAS bf16_t* vl = Vl + (ch >> 2) * 2048 + key * 32 + 8 * (ch & 3);
    LAS bf16_t* pl = Kl + (tid >> 2) * KSTR + 64 + 8 * (tid & 3);
    u32x4 kreg = *(const u32x4*)kg, vreg = *(const u32x4*)vg, preg;
    if (MODE == 1) preg = *(const u32x4*)(tid < 256 ? pg : kg);
    const LAS bf16_t* vrd = Vl + (4 * hi + ((lane & 15) >> 2)) * 32 + 16 * ((lane >> 4) & 1) + 4 * (lane & 3);
    for (int kt = 0; kt < nt; ++kt) {
        __syncthreads();
        *(LAS u32x4*)kl = kreg; *(LAS u32x4*)vl = vreg; if (MODE == 1 && tid < 256) *(LAS u32x4*)pl = preg;
        __syncthreads();
        if (kt + 1 < nt) { const size_t adv = (size_t)(kt + 1) * 64; kreg = *(const u32x4*)(kg + adv * kvs); vreg = *(const u32x4*)(vg + adv * kvs); if (MODE == 1) preg = *(const u32x4*)(tid < 256 ? pg + adv * 32 : kg); }
        if (MODE == 0) { attn_tile<2>(st0, Kl, KSTR, 0, qf, vrd, lane); attn_tile<2>(st1, Kl, KSTR, 32, qf + 2, vrd, lane); }
        else attn_tile<6>(st0, Kl, KSTR, 0, qf, vrd, lane);
    }
    bf16_t* Ob = (bf16_t*)(ws + WS_XN) + (size_t)qrow * 1024 + (MODE == 0 ? 0 : 384) + h * 64;
    const float l0 = st0.l + shx(st0.l, 32, lane); const float i0 = 1.0f / l0;
    float o[2][16];
    if (MODE == 0) {
        const float l1 = st1.l + shx(st1.l, 32, lane); const float i1 = lam / l1; float ss = 0.f;
#pragma unroll
        for (int db = 0; db < 2; ++db)
#pragma unroll
            for (int e = 0; e < 16; ++e) { const float v = st0.o[db][e] * i0 - st1.o[db][e] * i1; o[db][e] = v; ss += v * v; }
        ss += shx(ss, 32, lane);
        const float rinv = __builtin_amdgcn_rsqf(ss * (1.0f / 64.0f) + EPS) * (1.0f - lam_init);
        const float* sw = a.in[I_SUBLN] + (size_t)l * 64;
#pragma unroll
        for (int db = 0; db < 2; ++db)
#pragma unroll
            for (int e = 0; e < 16; ++e) o[db][e] *= rinv * sw[32 * db + (e & 3) + 8 * (e >> 2) + 4 * hi];
    } else {
#pragma unroll
        for (int db = 0; db < 2; ++db)
#pragma unroll
            for (int e = 0; e < 16; ++e) o[db][e] = st0.o[db][e] * i0;
    }
#pragma unroll
    for (int db = 0; db < 2; ++db)
#pragma unroll
        for (int rg = 0; rg < 4; ++rg) { u32x2 w; w.x = cvtpk(o[db][4 * rg], o[db][4 * rg + 1]); w.y = cvtpk(o[db][4 * rg + 2], o[db][4 * rg + 3]);
            *(u32x2*)(Ob + 32 * db + 8 * rg + 4 * hi) = w; }
}

__global__ void __launch_bounds__(NTHR, 2) mega_fwd(Args a) {
    extern __shared__ __attribute__((aligned(16))) unsigned char lds_raw[];
    LAS unsigned char* lds0 = (LAS unsigned char*)lds_raw;
    LAS unsigned char* lds = lds0 + 1024;
    cg::grid_group grid = cg::this_grid();
    const int G = gridDim.x, bx = blockIdx.x, ngw = G * NWAVES;
    const int wave0 = __builtin_amdgcn_readfirstlane((int)threadIdx.x >> 6);
    ArgTab tab = (ArgTab)lds0;
    if (threadIdx.x == 0) {
#pragma unroll
        for (int i = 0; i < 34; ++i) tab[i] = (unsigned long long)a.in[i];
        tab[34] = (unsigned long long)a.out; tab[35] = (unsigned long long)a.ws;
    }
    __syncthreads();
#define PH_BEGIN LAS unsigned char* tb_ = lds0; asm volatile("" : "+v"(tb_)); const Args b = load_args((ArgTab)tb_); int tid = wave0 * 64 + (int)__builtin_amdgcn_mbcnt_hi(~0u, __builtin_amdgcn_mbcnt_lo(~0u, 0u)); asm volatile("" : "+v"(tid)); const int lane = tid & 63, wave = __builtin_amdgcn_readfirstlane(tid >> 6), gw = bx * NWAVES + wave; unsigned char* ws = b.ws; (void)lane; (void)gw; (void)ws;
    { PH_BEGIN phase0(b, lds, tid, wave, lane); }
    grid.sync();
    for (int l = 0; l < 2; ++l) {
        { PH_BEGIN norm_phase(b, l, 0, l == 0, gw, ngw, lane); }
        grid.sync();
        { PH_BEGIN pg8::Gemm g{(const bf16_t*)(ws + WS_XN), (const bf16_t*)(ws + WS_W1 + (size_t)(l * 2 + 0) * W1_BYTES), T, 5632, 1024, 1024, 1024}; pg8::StaticOrder S; S.init(T, 5632, G, bx);
          pg8::EpiSwiglu E{(bf16_t*)(ws + WS_H)}; pg8::gemm_phase<pg8::EpiSwiglu, pg8::StaticOrder, true, true>(lds, g, S, E, tid); }
        grid.sync();
        { PH_BEGIN pg8::Gemm g{(const bf16_t*)(ws + WS_H), (const bf16_t*)(ws + WS_W2 + (size_t)(l * 2 + 0) * W2_BYTES), T, 1024, 2816, 2816, 2816}; pg8::StaticOrder S; S.init(T, 1024, G, bx);
          pg8::EpiResid E{l == 0 ? b.in[I_XP] : b.out, l == 0 ? b.in[I_XS] : b.out + (size_t)TC * DM, b.out, (const float*)(ws + WS_MOD) + (size_t)l * 5 * 9216 + 2 * DM, 0.5f};
          pg8::gemm_phase<pg8::EpiResid, pg8::StaticOrder, true, true>(lds, g, S, E, tid); }
        grid.sync();
        { PH_BEGIN norm_phase(b, l, 1, false, gw, ngw, lane); }
        grid.sync();
        { PH_BEGIN pg8::Gemm g{(const bf16_t*)(ws + WS_XN), (const bf16_t*)(ws + WS_WIN + (size_t)l * WIN_BYTES), T, 2048, 1024, 1024, 1024}; pg8::StaticOrder S; S.init(T, 2048, G, bx);
          pg8::EpiBf16 E{(bf16_t*)(ws + WS_P), 2048}; pg8::gemm_phase<pg8::EpiBf16, pg8::StaticOrder, true, true>(lds, g, S, E, tid); }
        grid.sync();
        { PH_BEGIN post_phase(b, l, gw, ngw, lane); }
        grid.sync();
        { PH_BEGIN pg8::Gemm g{(const bf16_t*)(ws + WS_CQN), (const bf16_t*)(ws + WS_WQ + (size_t)l * WQ_BYTES), T, 768, 256, 256, 256}; pg8::StaticOrder S; S.init(T, 768, G, bx);
          pg8::EpiBf16 E{(bf16_t*)(ws + WS_Q2), 768}; pg8::gemm_phase<pg8::EpiBf16, pg8::StaticOrder, true, true>(lds, g, S, E, tid); }
        { PH_BEGIN pg8::Gemm g{(const bf16_t*)(ws + WS_CKVN), (const bf16_t*)(ws + WS_WKV + (size_t)l * WKV_BYTES), KR, 768, 256, 256, 256}; pg8::StaticOrder S; S.init(KR, 768, G, (bx + 64) % G);
          pg8::EpiBf16 E{(bf16_t*)(ws + WS_KV), 768}; pg8::gemm_phase<pg8::EpiBf16, pg8::StaticOrder, true, true>(lds, g, S, E, tid); }
        { PH_BEGIN pg8::Gemm g{(const bf16_t*)(ws + WS_A2), (const bf16_t*)(ws + WS_E + (size_t)l * E_BYTES), 16384, 4096, 256, 512, 256}; pg8::GroupOrder S{64, G, (bx + 116) % G};
          pg8::EpiS5State E{(float*)(ws + WS_S)}; pg8::gemm_phase<pg8::EpiS5State, pg8::GroupOrder, true, true>(lds, g, S, E, tid); }
        grid.sync();
        { PH_BEGIN s5_combine_phase(b, l, gw, ngw, lane); }
        grid.sync();
        { PH_BEGIN pg8::Gemm g{(const bf16_t*)(ws + WS_A2), (const bf16_t*)(ws + WS_BCAT + (size_t)l * BCAT_BYTES), 16384, 4096, 512, 512, 512}; pg8::GroupOrder S{64, G, bx};
          pg8::EpiS5Y E{(bf16_t*)(ws + WS_CQN)}; pg8::gemm_phase<pg8::EpiS5Y, pg8::GroupOrder, true, true>(lds, g, S, E, tid); }
        {
            PH_BEGIN
            unsigned* ctl = (unsigned*)(ws + WS_CTL);
            const float lam_init = 0.8f - 0.6f * __expf(-0.3f * (float)l);
            const float* lp = b.in[I_DLAM] + (size_t)l * 128;
            float pr = lane < 32 ? lp[lane] * lp[32 + lane] : lp[64 + lane - 32] * lp[96 + lane - 32];
#pragma unroll
            for (int o = 1; o < 32; o <<= 1) pr += shx(pr, o, lane);
            const float lam = __expf(__builtin_bit_cast(float, __builtin_amdgcn_readlane(__builtin_bit_cast(int, pr), 0))) - __expf(__builtin_bit_cast(float, __builtin_amdgcn_readlane(__builtin_bit_cast(int, pr), 32))) + lam_init;
            volatile LAS int* qslot = (volatile LAS int*)(lds + 24576);
            for (;;) {
                __syncthreads();
                if (tid == 0) *qslot = (int)atomicAdd(ctl + CW_Q + 64 * l, 1u);
                __syncthreads();
                const int it = *qslot;
                if (it >= 384) break;
                const bool heavy = it < 192; const int j = heavy ? it : it - 192;
                attn_item<0>(b, lds, l, heavy ? 32 + j / 48 : j / 6, heavy ? (j % 48) >> 3 : j % 6, heavy ? (j & 7) : 0, lam, lam_init, tid, wave, lane);
            }
        }
        {
            PH_BEGIN
            unsigned* ctl = (unsigned*)(ws + WS_CTL);
            volatile LAS int* qslot = (volatile LAS int*)(lds + 24576);
            for (;;) {
                __syncthreads();
                if (tid == 0) *qslot = (int)atomicAdd(ctl + CW_Q + 64 * (2 + l), 1u);
                __syncthreads();
                const int it = *qslot;
                if (it >= 384) break;
                const bool heavy = it < 192; const int j = heavy ? it : it - 192;
                attn_item<1>(b, lds, l, heavy ? 32 + j / 48 : j / 6, heavy ? (j % 48) >> 3 : j % 6, heavy ? (j & 7) : 0, 0.f, 0.f, tid, wave, lane);
            }
        }
        grid.sync();
        { PH_BEGIN pg8::Gemm g{(const bf16_t*)(ws + WS_CQN), (const bf16_t*)(ws + WS_WGLU + (size_t)l * WGLU_BYTES), T, 256, 256, 256, 256}; pg8::StaticOrder S; S.init(T, 256, G, bx);
          pg8::EpiGlu E{(const bf16_t*)(ws + WS_CQN), b.in[I_BGLU] + (size_t)l * 256, (bf16_t*)(ws + WS_XN)}; pg8::gemm_phase<pg8::EpiGlu, pg8::StaticOrder, true, true>(lds, g, S, E, tid); }
        grid.sync();
        { PH_BEGIN pg8::Gemm g{(const bf16_t*)(ws + WS_XN), (const bf16_t*)(ws + WS_WOUT + (size_t)l * WOUT_BYTES), T, 1024, 1024, 1024, 1024}; pg8::StaticOrder S; S.init(T, 1024, G, bx);
          pg8::EpiResid E{b.out, b.out + (size_t)TC * DM, b.out, (const float*)(ws + WS_MOD) + (size_t)l * 5 * 9216 + 5 * DM, 1.0f};
          pg8::gemm_phase<pg8::EpiResid, pg8::StaticOrder, true, true>(lds, g, S, E, tid); }
        grid.sync();
        { PH_BEGIN norm_phase(b, l, 2, false, gw, ngw, lane); }
        grid.sync();
        { PH_BEGIN pg8::Gemm g{(const bf16_t*)(ws + WS_XN), (const bf16_t*)(ws + WS_W1 + (size_t)(l * 2 + 1) * W1_BYTES), T, 5632, 1024, 1024, 1024}; pg8::StaticOrder S; S.init(T, 5632, G, bx);
          pg8::EpiSwiglu E{(bf16_t*)(ws + WS_H)}; pg8::gemm_phase<pg8::EpiSwiglu, pg8::StaticOrder, true, true>(lds, g, S, E, tid); }
        grid.sync();
        { PH_BEGIN pg8::Gemm g{(const bf16_t*)(ws + WS_H), (const bf16_t*)(ws + WS_W2 + (size_t)(l * 2 + 1) * W2_BYTES), T, 1024, 2816, 2816, 2816}; pg8::StaticOrder S; S.init(T, 1024, G, bx);
          pg8::EpiResid E{b.out, b.out + (size_t)TC * DM, b.out, (const float*)(ws + WS_MOD) + (size_t)l * 5 * 9216 + 8 * DM, 0.5f};
          pg8::gemm_phase<pg8::EpiResid, pg8::StaticOrder, true, true>(lds, g, S, E, tid); }
        grid.sync();
    }
    { PH_BEGIN final_norm_phase(b, gw, ngw, lane); }
}

extern "C" void kernel_launch(void* const* d_in, const int* in_sizes, int n_in, void* d_out, int out_size, void* d_ws, size_t ws_size, hipStream_t stream) {
    static int grid = 0;
    if (grid == 0) {
        if (n_in != 34 || ws_size < WS_END) { fprintf(stderr, "kernel_launch: expected 34 inputs and >= %zu bytes of workspace; got %d, %zu\n", (size_t)WS_END, n_in, ws_size); grid = -1; return; }
        int dev = 0, cus = 0, per_cu = 0;
        if (hipGetDevice(&dev) != hipSuccess || hipDeviceGetAttribute(&cus, hipDeviceAttributeMultiprocessorCount, dev) != hipSuccess) { grid = -1; return; }
        if (hipFuncSetAttribute((const void*)mega_fwd, hipFuncAttributeMaxDynamicSharedMemorySize, LDS_BYTES) != hipSuccess) { fprintf(stderr, "kernel_launch: hipFuncSetAttribute failed\n"); grid = -1; return; }
        if (hipOccupancyMaxActiveBlocksPerMultiprocessor(&per_cu, (const void*)mega_fwd, NTHR, LDS_BYTES) != hipSuccess || per_cu < 1) { fprintf(stderr, "kernel_launch: occupancy query reports %d\n", per_cu); per_cu = 1; }
        (void)hipGetLastError();
        grid = cus * 1;
    }
    if (grid < 0) return;
    (void)hipMemsetAsync((char*)d_ws + WS_CTL, 0, CTL_BYTES, stream);
    Args a{};
    for (int i = 0; i < 34; ++i) a.in[i] = (const float*)d_in[i];
    a.out = (float*)d_out; a.ws = (unsigned char*)d_ws;
    void* params[] = {&a};
    hipError_t e = hipLaunchCooperativeKernel((const void*)mega_fwd, dim3(grid), dim3(NTHR), params, LDS_BYTES, stream);
    if (e != hipSuccess) fprintf(stderr, "cooperative launch failed: %s (grid %d)\n", hipGetErrorString(e), grid);
}
```

```cpp
#include <hip/hip_runtime.h>
#include <hip/hip_cooperative_groups.h>
#include <cstdio>
#include <cstdint>
namespace cg = cooperative_groups;

namespace pg8 {
#define PG8_LAS __attribute__((address_space(3)))
typedef unsigned short bf16_t;
typedef short bf16x8 __attribute__((ext_vector_type(8)));
typedef float f32x4 __attribute__((ext_vector_type(4)));
typedef unsigned u32x4 __attribute__((ext_vector_type(4)));
constexpr int BM = 256, BK = 64, HALF = 128, HTB = HALF * BK * 2  , STAGE_BYTES = 8 * HTB, NXCD = 8, WGM = 8;

__host__ __device__ __forceinline__ int lds_byte(int r, int c) { const int st = (r >> 4) * 2 + (c >> 5), rr = r & 15, cc = c & 31, ob = rr * 64 + cc * 2; return st * 1024 + (ob ^ (((ob >> 9) & 1) << 5)); }
__host__ __device__ __forceinline__ void stage_rc(int b, int& R, int& C) { const int st = b / 1024, sb = b % 1024, swz = sb ^ (((sb >> 9) & 1) << 5); R = (st >> 1) * 16 + swz / 64; C = (st & 1) * 32 + (swz % 64) / 2; }
__host__ __device__ __forceinline__ int perm32(int rho) { const int n = rho >> 4, i = rho & 15; return 8 * (i >> 2) + 4 * n + (i & 3); }

struct Unit { int pm, pn; };
struct Gemm { const bf16_t* A; const bf16_t* Bt; int M, N, K, lda, ldb; };

struct StaticOrder {
    int nM, nN, nwg, G, c;
    __host__ __device__ void init(int M, int N, int G_, int c_) { nM = M / BM; nN = N / BM; nwg = nM * nN; G = G_; c = c_; }
    __host__ __device__ bool next(int i, Unit& u) const {
        const long L = (long)i * G + c; if (L >= nwg) return false;
        int wgid = (int)L; { const int q = nwg / NXCD, r = nwg % NXCD, xcd = wgid % NXCD, off = wgid / NXCD; wgid = (xcd < r ? xcd * (q + 1) : r * (q + 1) + (xcd - r) * q) + off; }
        const int nig = WGM * nN, gid = wgid / nig, fm = gid * WGM, gsz = (nM - fm) < WGM ? (nM - fm) : WGM;
        u.pm = fm + ((wgid % nig) % gsz); u.pn = (wgid % nig) / gsz; return true;
    }
    __device__ __forceinline__ void a_ready(const Unit&) const {}
    __device__ __forceinline__ void done(const Unit&) const {}
};
struct GroupOrder {
    int n, G, c;
    __device__ bool next(int i, Unit& u) const { const int L = i * G + c; if (L >= n) return false; u.pm = L; u.pn = L >> 2; return true; }
    __device__ __forceinline__ void a_ready(const Unit&) const {}
    __device__ __forceinline__ void done(const Unit&) const {}
};
__device__ __forceinline__ unsigned cvt_pk_bf16(float lo, float hi) { unsigned r; asm volatile("v_cvt_pk_bf16_f32 %0, %1, %2" : "=v"(r) : "v"(lo), "v"(hi)); return r; }
__device__ __forceinline__ float fsigmoid(float z) { return __builtin_amdgcn_rcpf(1.0f + __expf(-z)); }
struct EpiBf16 {
    static constexpr bool PERM = true, AFTER_DRAIN = false;
    bf16_t* O; int ldc;
    __device__ __forceinline__ void operator()(const f32x4 (&acc)[2][2][4][2], const Unit& u, int wr, int wc, int fr, int fq) const {
        const int row0 = u.pm * BM + wr * 64 + fr; const int col0 = u.pn * BM + wc * 32 + 8 * fq;
#pragma unroll
        for (int ai = 0; ai < 2; ++ai)
#pragma unroll
            for (int m = 0; m < 4; ++m) { bf16_t* rowp = O + (size_t)(row0 + ai * HALF + m * 16) * ldc + col0;
#pragma unroll
                for (int bj = 0; bj < 2; ++bj) { const f32x4 v0 = acc[ai][bj][m][0], v1 = acc[ai][bj][m][1];
                    u32x4 w; w.x = cvt_pk_bf16(v0[0], v0[1]); w.y = cvt_pk_bf16(v0[2], v0[3]); w.z = cvt_pk_bf16(v1[0], v1[1]); w.w = cvt_pk_bf16(v1[2], v1[3]);
                    *(u32x4*)(rowp + bj * HALF) = w; } }
    }
};
struct EpiSwiglu {
    static constexpr bool PERM = true, AFTER_DRAIN = false;
    bf16_t* H;
    __device__ __forceinline__ void operator()(const f32x4 (&acc)[2][2][4][2], const Unit& u, int wr, int wc, int fr, int fq) const {
        const int row0 = u.pm * BM + wr * 64 + fr; const int col0 = u.pn * HALF + wc * 32 + 8 * fq;
#pragma unroll
        for (int ai = 0; ai < 2; ++ai)
#pragma unroll
            for (int m = 0; m < 4; ++m) { bf16_t* rowp = H + (size_t)(row0 + ai * HALF + m * 16) * 2816 + col0;
                float h[8];
#pragma unroll
                for (int n = 0; n < 2; ++n) { const f32x4 av = acc[ai][0][m][n], gv = acc[ai][1][m][n];
#pragma unroll
                    for (int e = 0; e < 4; ++e) h[4 * n + e] = av[e] * gv[e] * fsigmoid(gv[e]); }
                u32x4 w; w.x = cvt_pk_bf16(h[0], h[1]); w.y = cvt_pk_bf16(h[2], h[3]); w.z = cvt_pk_bf16(h[4], h[5]); w.w = cvt_pk_bf16(h[6], h[7]);
                *(u32x4*)rowp = w; }
    }
};
struct EpiResid {
    static constexpr bool PERM = false, AFTER_DRAIN = false;
    const float* resA; const float* resB; float* out; const float* gate; float gs;
    __device__ __forceinline__ void operator()(const f32x4 (&acc)[2][2][4][2], const Unit& u, int wr, int wc, int fr, int fq) const {
        const int row0 = u.pm * BM + wr * 64 + fr; const int col0 = u.pn * BM + wc * 32 + 4 * fq;
        const int cond = (u.pm < 32) ? 0 : 1 + ((u.pm - 32) >> 3);
        const float* gp = gate + (size_t)cond * 9216 + col0;
        f32x4 gv[2][2];
#pragma unroll
        for (int bj = 0; bj < 2; ++bj)
#pragma unroll
            for (int n = 0; n < 2; ++n) gv[bj][n] = *(const f32x4*)(gp + bj * HALF + n * 16) * gs;
#pragma unroll
        for (int ai = 0; ai < 2; ++ai)
#pragma unroll
            for (int m = 0; m < 4; ++m) { const int row = row0 + ai * HALF + m * 16;
                const float* rp = (row < 8192 ? resA + (size_t)row * 1024 : resB + (size_t)(row - 8192) * 1024) + col0; float* op = out + (size_t)row * 1024 + col0;
#pragma unroll
                for (int bj = 0; bj < 2; ++bj)
#pragma unroll
                    for (int n = 0; n < 2; ++n) { const f32x4 r = *(const f32x4*)(rp + bj * HALF + n * 16); *(f32x4*)(op + bj * HALF + n * 16) = r + gv[bj][n] * acc[ai][bj][m][n]; } }
    }
};
struct EpiS5State {
    static constexpr bool PERM = false, AFTER_DRAIN = false;
    float* S;
    __device__ __forceinline__ void operator()(const f32x4 (&acc)[2][2][4][2], const Unit& u, int wr, int wc, int fr, int fq) const {
        const int row0 = u.pm * BM + wr * 64 + fr; const int col0 = wc * 32 + 4 * fq;
#pragma unroll
        for (int ai = 0; ai < 2; ++ai)
#pragma unroll
            for (int m = 0; m < 4; ++m) { float* op = S + (size_t)(row0 + ai * HALF + m * 16) * 256 + col0;
#pragma unroll
                for (int bj = 0; bj < 2; ++bj)
#pragma unroll
                    for (int n = 0; n < 2; ++n) *(f32x4*)(op + bj * HALF + n * 16) = acc[ai][bj][m][n]; }
    }
};
__device__ __forceinline__ float gelu_tanh(float x) { const float z = 1.5957691216f * (x + 0.044715f * x * x * x); return x * fsigmoid(z); }
struct EpiS5Y {
    static constexpr bool PERM = true, AFTER_DRAIN = false;
    bf16_t* YG;
    __device__ __forceinline__ void operator()(const f32x4 (&acc)[2][2][4][2], const Unit& u, int wr, int wc, int fr, int fq) const {
        const int row0 = (u.pm & 3) * BM + wr * 64 + fr; const int g = u.pn;
#pragma unroll
        for (int ai = 0; ai < 2; ++ai)
#pragma unroll
            for (int m = 0; m < 4; ++m) { const int rloc = row0 + ai * HALF + m * 16;
#pragma unroll
                for (int bj = 0; bj < 2; ++bj) { const int j = bj * HALF + wc * 32 + 8 * fq; const int tok = rloc * 16 + (j >> 4);
                    const f32x4 v0 = acc[ai][bj][m][0], v1 = acc[ai][bj][m][1];
                    u32x4 w; w.x = cvt_pk_bf16(gelu_tanh(v0[0]), gelu_tanh(v0[1])); w.y = cvt_pk_bf16(gelu_tanh(v0[2]), gelu_tanh(v0[3]));
                    w.z = cvt_pk_bf16(gelu_tanh(v1[0]), gelu_tanh(v1[1])); w.w = cvt_pk_bf16(gelu_tanh(v1[2]), gelu_tanh(v1[3]));
                    *(u32x4*)(YG + (size_t)tok * 256 + g * 16 + (j & 15)) = w; } }
    }
};
struct EpiGlu {
    static constexpr bool PERM = true, AFTER_DRAIN = false;
    const bf16_t* YG; const float* bias; bf16_t* O;
    __device__ __forceinline__ void operator()(const f32x4 (&acc)[2][2][4][2], const Unit& u, int wr, int wc, int fr, int fq) const {
        const int row0 = u.pm * BM + wr * 64 + fr; const int col0 = wc * 32 + 8 * fq;
#pragma unroll
        for (int ai = 0; ai < 2; ++ai)
#pragma unroll
            for (int m = 0; m < 4; ++m) { const int row = row0 + ai * HALF + m * 16;
#pragma unroll
                for (int bj = 0; bj < 2; ++bj) { const int col = col0 + bj * HALF;
                    const u32x4 y = *(const u32x4*)(YG + (size_t)row * 256 + col);
                    const f32x4 b0 = *(const f32x4*)(bias + col), b1 = *(const f32x4*)(bias + col + 4);
                    const f32x4 v0 = acc[ai][bj][m][0] + b0, v1 = acc[ai][bj][m][1] + b1;
                    float yy[8]; yy[0] = __uint_as_float(y.x << 16); yy[1] = __uint_as_float(y.x & 0xffff0000u); yy[2] = __uint_as_float(y.y << 16); yy[3] = __uint_as_float(y.y & 0xffff0000u);
                    yy[4] = __uint_as_float(y.z << 16); yy[5] = __uint_as_float(y.z & 0xffff0000u); yy[6] = __uint_as_float(y.w << 16); yy[7] = __uint_as_float(y.w & 0xffff0000u);
                    u32x4 w; w.x = cvt_pk_bf16(yy[0] * fsigmoid(v0[0]), yy[1] * fsigmoid(v0[1])); w.y = cvt_pk_bf16(yy[2] * fsigmoid(v0[2]), yy[3] * fsigmoid(v0[3]));
                    w.z = cvt_pk_bf16(yy[4] * fsigmoid(v1[0]), yy[5] * fsigmoid(v1[1])); w.w = cvt_pk_bf16(yy[6] * fsigmoid(v1[2]), yy[7] * fsigmoid(v1[3]));
                    *(u32x4*)(O + (size_t)row * 1024 + 768 + col) = w; asm volatile("" ::: "memory"); } }
    }
};

template <class Epi, class Sched, bool ALIGN_EPI = false, bool SP2 = false>
__device__ __forceinline__ void gemm_phase(PG8_LAS unsigned char* lds, const Gemm g, const Sched& S, const Epi& E, int tid_in) {
    int tid_ = tid_in; asm volatile("" : "+v"(tid_));
    const int tid = tid_, wid = __builtin_amdgcn_readfirstlane(tid >> 6), lane = tid & 63, wr = wid >> 2, wc = wid & 3, fr = lane & 15, fq = lane >> 4;
    int K_ = g.K; asm volatile("" : "+s"(K_));
    const int K = K_, nt = K / BK;
    unsigned voffA[2], voffB[2];
#pragma unroll
    for (int i = 0; i < 2; ++i) { int R, C; stage_rc(tid * 16 + i * 8192, R, C); const int Rb = Epi::PERM ? ((R & ~31) + perm32(R & 31)) : R;
        voffA[i] = (unsigned)(R * g.lda + C) * 2u; voffB[i] = (unsigned)(Rb * g.ldb + C) * 2u; }
    const size_t kstep = (size_t)(BK * 2);
    const size_t hsA = (size_t)HALF * g.lda * 2, hsB = (size_t)HALF * g.ldb * 2;
    const size_t tsA = 2 * hsA, tsB = 2 * hsB;
    const unsigned ldsw = (unsigned)wid * 1024u;
    const int aoff = lds_byte(wr * 64 + fr, fq * 8), boff = lds_byte(wc * 32 + fr, fq * 8);
#define PG8_SA(b, h) (((b) * 2 + (h)) * HTB)
#define PG8_SB(b, h) ((4 + (b) * 2 + (h)) * HTB)
#define PG8_STAGE(bufoff, gbase, voff) do { _Pragma("unroll") for (int _i = 0; _i < 2; ++_i) \
        __builtin_amdgcn_global_load_lds((const unsigned*)((const char*)(gbase) + (voff)[_i]), (PG8_LAS unsigned*)(lds + (bufoff) + ldsw + _i * 8192), 16, 0, 0); } while (0)
#define PG8_LDA(dst, b, h) do { _Pragma("unroll") for (int m = 0; m < 4; ++m) _Pragma("unroll") for (int k = 0; k < 2; ++k) dst[m][k] = *(const PG8_LAS bf16x8*)(lds + PG8_SA(b, h) + aoff + m * 2048 + k * 1024); } while (0)
#define PG8_LDB(dst, b, h) do { _Pragma("unroll") for (int n = 0; n < 2; ++n) _Pragma("unroll") for (int k = 0; k < 2; ++k) dst[n][k] = *(const PG8_LAS bf16x8*)(lds + PG8_SB(b, h) + boff + n * 2048 + k * 1024); } while (0)
#define PG8_MMA(ai, bj, At, Bt) do { __builtin_amdgcn_s_setprio(1); _Pragma("unroll") for (int m = 0; m < 4; ++m) _Pragma("unroll") for (int n = 0; n < 2; ++n) _Pragma("unroll") for (int k = 0; k < 2; ++k) \
        acc[ai][bj][m][n] = __builtin_amdgcn_mfma_f32_16x16x32_bf16(Bt[n][k], At[m][k], acc[ai][bj][m][n], 0, 0, 0); __builtin_amdgcn_s_setprio(0); } while (0)
#define PG8_WAIT_V(n) asm volatile("s_waitcnt vmcnt(" #n ")" ::: "memory")
#define PG8_WAIT_L(n) asm volatile("s_waitcnt lgkmcnt(" #n ")" ::: "memory")
#define PG8_BAR __builtin_amdgcn_s_barrier()
#define PG8_SCHED __builtin_amdgcn_sched_barrier(0)
    Unit cur, nxt; int ui = 0;
    if (!S.next(0, cur)) return;
    f32x4 acc[2][2][4][2];
#pragma unroll
    for (int a = 0; a < 2; ++a)
#pragma unroll
        for (int b = 0; b < 2; ++b)
#pragma unroll
            for (int m = 0; m < 4; ++m)
#pragma unroll
                for (int n = 0; n < 2; ++n) acc[a][b][m][n] = (f32x4){0.f, 0.f, 0.f, 0.f};
    bf16x8 At[4][2], B0[2][2], B1[2][2];
    const char* cA = (const char*)g.A + (size_t)cur.pm * tsA; const char* cB = (const char*)g.Bt + (size_t)cur.pn * tsB;
    S.a_ready(cur);
    if constexpr (SP2) {
        PG8_STAGE(PG8_SB(0, 0), cB, voffB); PG8_STAGE(PG8_SB(0, 1), cB + hsB, voffB); PG8_STAGE(PG8_SA(0, 0), cA, voffA); PG8_STAGE(PG8_SA(0, 1), cA + hsA, voffA);
        if (wr == 1) PG8_BAR;
        PG8_WAIT_V(2); PG8_BAR;
        PG8_STAGE(PG8_SB(1, 0), cB + kstep, voffB); PG8_STAGE(PG8_SA(1, 0), cA + kstep, voffA); PG8_STAGE(PG8_SB(1, 1), cB + hsB + kstep, voffB);
        PG8_WAIT_V(6); PG8_BAR;
    } else {
        PG8_STAGE(PG8_SB(0, 0), cB, voffB); PG8_STAGE(PG8_SA(0, 0), cA, voffA); PG8_STAGE(PG8_SB(0, 1), cB + hsB, voffB); PG8_STAGE(PG8_SA(0, 1), cA + hsA, voffA);
        if (wr == 1) PG8_BAR;
        PG8_WAIT_V(4); PG8_BAR;
        PG8_STAGE(PG8_SB(1, 0), cB + kstep, voffB); PG8_STAGE(PG8_SA(1, 0), cA + kstep, voffA); PG8_STAGE(PG8_SB(1, 1), cB + hsB + kstep, voffB);
        PG8_WAIT_V(6); PG8_BAR;
    }
    for (;;) {
        const bool has_next = S.next(ui + 1, nxt);
        const char* nA = has_next ? (const char*)g.A + (size_t)nxt.pm * tsA : cA; const char* nB = has_next ? (const char*)g.Bt + (size_t)nxt.pn * tsB : cB;
        for (int t = 0; t < nt; t += 2) {
            const bool last = (t == nt - 2);
            const char* a1 = cA + (size_t)(t + 1) * kstep;
            const char* a2 = last ? nA : cA + (size_t)(t + 2) * kstep; const char* b2 = last ? nB : cB + (size_t)(t + 2) * kstep;
            const char* a3 = a2 + kstep; const char* b3 = b2 + kstep;
            if (last && has_next) S.a_ready(nxt);
            if constexpr (SP2) {
            PG8_LDB(B0, 0, 0); PG8_LDB(B1, 0, 1); PG8_SCHED; PG8_LDA(At, 0, 0); PG8_STAGE(PG8_SA(1, 1), a1 + hsA, voffA);
            PG8_WAIT_V(8); PG8_WAIT_L(0); PG8_BAR; PG8_MMA(0, 0, At, B0); PG8_MMA(0, 1, At, B1); PG8_BAR; PG8_SCHED;
            PG8_LDA(At, 0, 1); PG8_STAGE(PG8_SB(0, 0), b2, voffB); PG8_STAGE(PG8_SB(0, 1), b2 + hsB, voffB); PG8_STAGE(PG8_SA(0, 0), a2, voffA);
            PG8_WAIT_V(8); PG8_WAIT_L(0); PG8_BAR; PG8_MMA(1, 0, At, B0); PG8_MMA(1, 1, At, B1); PG8_BAR; PG8_SCHED;
            PG8_LDB(B0, 1, 0); PG8_LDB(B1, 1, 1); PG8_SCHED; PG8_LDA(At, 1, 0); PG8_STAGE(PG8_SA(0, 1), a2 + hsA, voffA);
            PG8_WAIT_V(8); PG8_WAIT_L(0); PG8_BAR; PG8_MMA(0, 0, At, B0); PG8_MMA(0, 1, At, B1); PG8_BAR; PG8_SCHED;
            PG8_LDA(At, 1, 1); PG8_STAGE(PG8_SB(1, 0), b3, voffB); PG8_STAGE(PG8_SB(1, 1), b3 + hsB, voffB); PG8_STAGE(PG8_SA(1, 0), a3, voffA);
            PG8_WAIT_V(8); PG8_WAIT_L(0); PG8_BAR; PG8_MMA(1, 0, At, B0); PG8_MMA(1, 1, At, B1); PG8_BAR; PG8_SCHED;
            } else {
            PG8_LDB(B0, 0, 0); PG8_SCHED; PG8_LDA(At, 0, 0); PG8_STAGE(PG8_SA(1, 1), a1 + hsA, voffA);
            PG8_WAIT_L(8); PG8_BAR; PG8_WAIT_L(0); PG8_MMA(0, 0, At, B0); PG8_BAR; PG8_SCHED;
            PG8_LDB(B1, 0, 1); PG8_STAGE(PG8_SB(0, 0), b2, voffB);
            PG8_BAR; PG8_WAIT_L(0); PG8_MMA(0, 1, At, B1); PG8_BAR;
            PG8_LDA(At, 0, 1); PG8_STAGE(PG8_SA(0, 0), a2, voffA);
            PG8_BAR; PG8_WAIT_L(0); PG8_MMA(1, 0, At, B0); PG8_BAR; PG8_SCHED;
            PG8_STAGE(PG8_SB(0, 1), b2 + hsB, voffB);
            PG8_WAIT_V(6); PG8_BAR; PG8_MMA(1, 1, At, B1); PG8_BAR;
            PG8_LDB(B0, 1, 0); PG8_SCHED; PG8_LDA(At, 1, 0); PG8_STAGE(PG8_SA(0, 1), a2 + hsA, voffA);
            PG8_WAIT_L(8); PG8_BAR; PG8_WAIT_L(0); PG8_MMA(0, 0, At, B0); PG8_BAR; PG8_SCHED;
            PG8_LDB(B1, 1, 1); PG8_STAGE(PG8_SB(1, 0), b3, voffB);
            PG8_BAR; PG8_WAIT_L(0); PG8_MMA(0, 1, At, B1); PG8_BAR;
            PG8_LDA(At, 1, 1); PG8_STAGE(PG8_SA(1, 0), a3, voffA);
            PG8_BAR; PG8_WAIT_L(0); PG8_MMA(1, 0, At, B0); PG8_BAR; PG8_SCHED;
            PG8_STAGE(PG8_SB(1, 1), b3 + hsB, voffB);
            PG8_WAIT_V(6); PG8_BAR; PG8_MMA(1, 1, At, B1); PG8_BAR;
            }
        }
        if constexpr (ALIGN_EPI) { if (wr == 0) PG8_BAR; }
        if constexpr (!Epi::AFTER_DRAIN) { E(acc, cur, wr, wc, fr, fq); S.done(cur); }
        if (!has_next) break;
#pragma unroll
        for (int a = 0; a < 2; ++a)
#pragma unroll
            for (int b = 0; b < 2; ++b)
#pragma unroll
                for (int m = 0; m < 4; ++m)
#pragma unroll
                    for (int n = 0; n < 2; ++n) acc[a][b][m][n] = (f32x4){0.f, 0.f, 0.f, 0.f};
        cur = nxt; cA = nA; cB = nB; ++ui;
        if constexpr (ALIGN_EPI) { if (wr == 1) PG8_BAR; }
    }
    PG8_WAIT_V(0);
    if constexpr (!ALIGN_EPI) { if (wr == 0) PG8_BAR; }
    PG8_BAR;
    if constexpr (Epi::AFTER_DRAIN) { E.fused(acc, cur, wr, wc, fr, fq, lds, wid, lane); S.done(cur); }
#undef PG8_SA
#undef PG8_SB
#undef PG8_STAGE
#undef PG8_LDA
#undef PG8_LDB
#undef PG8_MMA
#undef PG8_WAIT_V
#undef PG8_WAIT_L
#undef PG8_BAR
#undef PG8_SCHED
}
}

#define LAS __attribute__((address_space(3)))
typedef unsigned short bf16_t;
typedef short bf16x8 __attribute__((ext_vector_type(8)));
typedef short s16x4 __attribute__((ext_vector_type(4)));
typedef float f32x4 __attribute__((ext_vector_type(4)));
typedef float f32x16 __attribute__((ext_vector_type(16)));
typedef unsigned u32x4 __attribute__((ext_vector_type(4)));
typedef unsigned u32x2 __attribute__((ext_vector_type(2)));
typedef float f32x2_t __attribute__((ext_vector_type(2)));
typedef __bf16 bf16x2_t __attribute__((ext_vector_type(2)));

constexpr int T = 16384, TC = 8192, DM = 1024, FF = 2816, KR = 17408;
constexpr int NTHR = 512, NWAVES = 8;
constexpr float EPS = 1e-6f;
constexpr size_t MiB = 1u << 20;
constexpr size_t WS_CTL = 0, CTL_BYTES = 32768;
constexpr size_t WS_MOD = 1 * MiB;
constexpr size_t WS_ROPE = 1 * MiB + 512 * 1024;
constexpr size_t WS_W1 = 2 * MiB, W1_BYTES = (size_t)5632 * 1024 * 2;
constexpr size_t WS_W2 = 46 * MiB, W2_BYTES = (size_t)1024 * 2816 * 2;
constexpr size_t WS_WIN = 68 * MiB, WIN_BYTES = (size_t)2048 * 1024 * 2;
constexpr size_t WS_WOUT = 76 * MiB, WOUT_BYTES = (size_t)1024 * 1024 * 2;
constexpr size_t WS_WQ = 80 * MiB, WQ_BYTES = (size_t)768 * 256 * 2;
constexpr size_t WS_WKV = WS_WQ + 2 * WQ_BYTES, WKV_BYTES = (size_t)768 * 256 * 2;
constexpr size_t WS_WGLU = WS_WKV + 2 * WKV_BYTES, WGLU_BYTES = (size_t)256 * 256 * 2;
constexpr size_t WS_BCAT = 82 * MiB, BCAT_BYTES = (size_t)16 * 256 * 512 * 2;
constexpr size_t WS_E = 90 * MiB, E_BYTES = (size_t)16 * 256 * 256 * 2;
constexpr size_t WS_XN = 94 * MiB;
constexpr size_t WS_H = 126 * MiB;
constexpr size_t WS_P = 126 * MiB;
constexpr size_t WS_Q2 = 126 * MiB;
constexpr size_t WS_KV = 150 * MiB;
constexpr size_t WS_QD = 190 * MiB;
constexpr size_t WS_KD = 214 * MiB;
constexpr size_t WS_VD = 227 * MiB;
constexpr size_t WS_CQN = 240 * MiB;
constexpr size_t WS_CKVN = 248 * MiB;
constexpr size_t WS_KPE = 257 * MiB;
constexpr size_t WS_A2 = 259 * MiB;
constexpr size_t WS_S = 275 * MiB;
constexpr size_t WS_END = 291 * MiB;
constexpr int CW_BAR = 1024;
constexpr int CW_Q = 64;
constexpr int LDS_BYTES = 147456;
constexpr size_t OUT_DK = 16777216, OUT_DV = 23068672, OUT_CKV = 29360128, OUT_KPE = 31457280, OUT_SRE = 31981568, OUT_SIM = 32112640;

struct Args { const float* in[34]; float* out; unsigned char* ws; };
enum { I_XP = 0, I_XS, I_CDK, I_CDV, I_CCKV, I_CKPE, I_SRE, I_SIM, I_C, I_CCTX, I_WADA, I_BADA, I_NORMW, I_FFNIN, I_FFNOUT, I_WIN, I_DLAM, I_SUBLN, I_QNW, I_WQUP, I_KVNW, I_WKVUP,
       I_ARE, I_AIM, I_LSTEP, I_BRE, I_BIM, I_CRE, I_CIM, I_S5D, I_WGLU, I_BGLU, I_WOUT, I_FNW };

typedef volatile LAS unsigned long long* ArgTab;
__device__ __forceinline__ unsigned long long ldarg(ArgTab t, int i) { const unsigned long long v = t[i]; const unsigned lo = __builtin_amdgcn_readfirstlane((unsigned)v), hi = __builtin_amdgcn_readfirstlane((unsigned)(v >> 32)); return ((unsigned long long)hi << 32) | lo; }
__device__ __forceinline__ Args load_args(ArgTab t) { Args b;
#pragma unroll
    for (int i = 0; i < 34; ++i) b.in[i] = (const float*)ldarg(t, i);
    b.out = (float*)ldarg(t, 34); b.ws = (unsigned char*)ldarg(t, 35); return b; }
#define LDS_WAIT() asm volatile("s_waitcnt lgkmcnt(0)" ::: "memory")
__device__ __forceinline__ unsigned cvtpk(float lo, float hi) { f32x2_t v = {lo, hi}; bf16x2_t b = __builtin_convertvector(v, bf16x2_t); return __builtin_bit_cast(unsigned, b); }
__device__ __forceinline__ float bflo(unsigned w) { return __uint_as_float(w << 16); }
__device__ __forceinline__ float bfhi(unsigned w) { return __uint_as_float(w & 0xffff0000u); }
__device__ __forceinline__ float shx(float v, int o, int lane) { return __builtin_bit_cast(float, __builtin_amdgcn_ds_bpermute((lane ^ o) << 2, __builtin_bit_cast(int, v))); }
__device__ __forceinline__ float wave_sum(float v, int lane) {
#pragma unroll
    for (int o = 1; o < 64; o <<= 1) v += shx(v, o, lane);
    return v;
}
__device__ __forceinline__ void sincos_rev(float ang, float& s, float& c) {
    float rev = ang * 0.15915494309189535f; rev -= floorf(rev);
    s = __builtin_amdgcn_sinf(rev); c = __builtin_amdgcn_cosf(rev);
}
__device__ __forceinline__ void unpack8(const u32x4 r, float (&v)[8]) {
    v[0] = bflo(r.x); v[1] = bfhi(r.x); v[2] = bflo(r.y); v[3] = bfhi(r.y); v[4] = bflo(r.z); v[5] = bfhi(r.z); v[6] = bflo(r.w); v[7] = bfhi(r.w);
}
__device__ __forceinline__ u32x4 pack8(const float (&v)[8]) { u32x4 w; w.x = cvtpk(v[0], v[1]); w.y = cvtpk(v[2], v[3]); w.z = cvtpk(v[4], v[5]); w.w = cvtpk(v[6], v[7]); return w; }

__device__ __forceinline__ void transpose_item(const float* W, int ldw, int k0, int nsrc0, bf16_t* WT, int ldt, int ndst0, LAS float* scr, int lane) {
#pragma unroll 8
    for (int i = 0; i < 32; ++i) { const int kk = 2 * i + (lane >> 5); scr[kk * 33 + (lane & 31)] = W[(size_t)(k0 + kk) * ldw + nsrc0 + (lane & 31)]; }
    LDS_WAIT(); asm volatile("" ::: "memory");
    const int c = lane & 7;
#pragma unroll
    for (int j = 0; j < 4; ++j) { const int n = (lane >> 3) + 8 * j; const LAS float* s = scr + (8 * c) * 33 + n;
        u32x4 o; o.x = cvtpk(s[0 * 33], s[1 * 33]); o.y = cvtpk(s[2 * 33], s[3 * 33]); o.z = cvtpk(s[4 * 33], s[5 * 33]); o.w = cvtpk(s[6 * 33], s[7 * 33]);
        *(u32x4*)(WT + (size_t)(ndst0 + n) * ldt + k0 + 8 * c) = o; }
    LDS_WAIT(); asm volatile("" ::: "memory");
}
__device__ __forceinline__ void convert_weights(const Args& a, LAS unsigned char* lds, int gw, int ngw, int wave, int lane) {
    LAS float* scr = (LAS float*)(lds + wave * 16384);
    unsigned char* ws = a.ws;
    constexpr int I_1 = 16 * 176, I_2 = 44 * 32, I_IN = 16 * 57, I_O = 16 * 32, I_Q = 4 * 18, I_KV = 2 * 24, I_G = 4 * 8;
    constexpr int NITEMS = 4 * I_1 + 4 * I_2 + 2 * I_IN + 2 * I_O + 2 * I_Q + 2 * I_KV + 2 * I_G;
    for (int it = gw; it < NITEMS; it += ngw) {
        int r = it;
        if (r < 4 * I_1) { const int mi = r / I_1, q = r % I_1, kb = q / 176, nb = q % 176, nd = nb * 32;
            const int ns = ((nd >> 7) & 1) * 2816 + (nd >> 8) * 128 + (nd & 127);
            transpose_item(a.in[I_FFNIN] + (size_t)mi * 1024 * 5632, 5632, kb * 64, ns, (bf16_t*)(ws + WS_W1 + mi * W1_BYTES), 1024, nd, scr, lane); continue; }
        r -= 4 * I_1;
        if (r < 4 * I_2) { const int mi = r / I_2, q = r % I_2, kb = q / 32, nb = q % 32;
            transpose_item(a.in[I_FFNOUT] + (size_t)mi * 2816 * 1024, 1024, kb * 64, nb * 32, (bf16_t*)(ws + WS_W2 + mi * W2_BYTES), 2816, nb * 32, scr, lane); continue; }
        r -= 4 * I_2;
        if (r < 2 * I_IN) { const int mi = r / I_IN, q = r % I_IN, kb = q / 57, nb = q % 57;
            transpose_item(a.in[I_WIN] + (size_t)mi * 1024 * 1824, 1824, kb * 64, nb * 32, (bf16_t*)(ws + WS_WIN + mi * WIN_BYTES), 1024, nb * 32, scr, lane); continue; }
        r -= 2 * I_IN;
        if (r < 2 * I_O) { const int mi = r / I_O, q = r % I_O, kb = q / 32, nb = q % 32;
            transpose_item(a.in[I_WOUT] + (size_t)mi * 1024 * 1024, 1024, kb * 64, nb * 32, (bf16_t*)(ws + WS_WOUT + mi * WOUT_BYTES), 1024, nb * 32, scr, lane); continue; }
        r -= 2 * I_O;
        if (r < 2 * I_Q) { const int mi = r / I_Q, q = r % I_Q, kb = q / 18, nb = q % 18;
            transpose_item(a.in[I_WQUP] + (size_t)mi * 256 * 576, 576, kb * 64, nb * 32, (bf16_t*)(ws + WS_WQ + mi * WQ_BYTES), 256, nb * 32, scr, lane); continue; }
        r -= 2 * I_Q;
        if (r < 2 * I_KV) { const int mi = r / I_KV, q = r % I_KV, kb = q / 24, nb = q % 24;
            bf16_t* dst = (bf16_t*)(ws + WS_WKV + mi * WKV_BYTES);
            transpose_item(a.in[I_WKVUP] + (size_t)mi * 128 * 768, 768, kb * 64, nb * 32, dst, 256, nb * 32, scr, lane);
            { const int n = lane >> 1, half = lane & 1; unsigned z0 = 0u; asm volatile("" : "+v"(z0)); const u32x4 z = {z0, z0, z0, z0};
#pragma unroll
              for (int j = 0; j < 4; ++j) *(u32x4*)(dst + (size_t)(nb * 32 + n) * 256 + 128 + kb * 64 + half * 32 + j * 8) = z; }
            continue; }
        r -= 2 * I_KV;
        { const int mi = r / I_G, q = r % I_G, kb = q / 8, nb = q % 8;
            transpose_item(a.in[I_WGLU] + (size_t)mi * 256 * 256, 256, kb * 64, nb * 32, (bf16_t*)(ws + WS_WGLU + mi * WGLU_BYTES), 256, nb * 32, scr, lane); }
    }
}
__device__ __forceinline__ void adaln_item(const Args& a, LAS unsigned char* lds, int item, int tid) {
    LAS float* sc = (LAS float*)lds;
    LAS float* red = (LAS float*)(lds + 20480);
    const int l = item / 72, chunk = item % 72;
    for (int i = tid; i < 5 * 1024; i += NTHR) { const int cd = i >> 10, k = i & 1023; const float v = cd == 0 ? a.in[I_CCTX][k] : a.in[I_C][(cd - 1) * 1024 + k]; sc[i] = v * __builtin_amdgcn_rcpf(1.0f + __expf(-v)); }
    __syncthreads();
    const int cg4 = tid & 31, kg = tid >> 5;
    const float* wp = a.in[I_WADA] + ((size_t)l * 1024 + kg * 64) * 9216 + chunk * 128 + 4 * cg4;
    f32x4 acc[5];
#pragma unroll
    for (int c = 0; c < 5; ++c) acc[c] = (f32x4){0.f, 0.f, 0.f, 0.f};
#pragma unroll 4
    for (int k = 0; k < 64; ++k) { const f32x4 w = *(const f32x4*)(wp + (size_t)k * 9216);
#pragma unroll
        for (int c = 0; c < 5; ++c) acc[c] += w * sc[c * 1024 + kg * 64 + k]; }
#pragma unroll
    for (int c = 0; c < 5; ++c) *(LAS f32x4*)(red + (kg * 5 + c) * 128 + 4 * cg4) = acc[c];
    __syncthreads();
    for (int o = tid; o < 640; o += NTHR) { const int c = o >> 7, col = o & 127; float s = 0.f;
#pragma unroll
        for (int k = 0; k < 16; ++k) s += red[(k * 5 + c) * 128 + col];
        const int gc = chunk * 128 + col;
        ((float*)(a.ws + WS_MOD))[((size_t)l * 5 + c) * 9216 + gc] = s + a.in[I_BADA][(size_t)l * 9216 + gc]; }
    __syncthreads();
}
__device__ __forceinline__ void s5gen_item(const Args& a, LAS unsigned char* lds, int item, int tid) {
    const int l = item >> 4, g = item & 15;
    LAS float* pwr = (LAS float*)lds;
    LAS float* pwi = pwr + 2 * 64 * 17;
    LAS float* bbr = pwi + 2 * 64 * 17;
    LAS float* bbi = bbr + 2 * 64 * 16;
    LAS float* cr = bbi + 2 * 64 * 16;
    LAS float* ci = cr + 2 * 16 * 64;
    LAS float* klag = ci + 2 * 16 * 64;
    if (tid < 128) { const int d = tid >> 6, p = tid & 63; const size_t ix = (((size_t)l * 2 + d) * 16 + g) * 64 + p;
        const float are = a.in[I_ARE][ix], aim = a.in[I_AIM][ix], st = __expf(a.in[I_LSTEP][((size_t)l * 2 + d) * 16 + g]);
        float l1r = 0.f, l1i = 0.f;
        for (int k = 0; k <= 16; ++k) { const float mag = __expf((float)k * are * st); float s, c; sincos_rev((float)k * aim * st, s, c);
            pwr[(d * 64 + p) * 17 + k] = mag * c; pwi[(d * 64 + p) * 17 + k] = mag * s; if (k == 1) { l1r = mag * c; l1i = mag * s; } }
        const float xr = l1r - 1.0f, xi = l1i, den = 1.0f / (are * are + aim * aim);
        const float cfr = (xr * are + xi * aim) * den, cfi = (xi * are - xr * aim) * den;
        for (int c = 0; c < 16; ++c) { const float br = a.in[I_BRE][ix * 16 + c], bi = a.in[I_BIM][ix * 16 + c];
            bbr[(d * 64 + p) * 16 + c] = cfr * br - cfi * bi; bbi[(d * 64 + p) * 16 + c] = cfr * bi + cfi * br; }
    }
    for (int i = tid; i < 2048; i += NTHR) { const int d = i >> 10, co = (i >> 6) & 15, p = i & 63; const size_t ix = ((((size_t)l * 2 + d) * 16 + g) * 16 + co) * 64 + p;
        cr[i] = a.in[I_CRE][ix]; ci[i] = a.in[I_CIM][ix]; }
    __syncthreads();
    for (int i = tid; i < 8192; i += NTHR) { const int d = i >> 12, j = (i >> 8) & 15, co = (i >> 4) & 15, cin = i & 15; float s = 0.f;
        for (int p = 0; p < 64; ++p) { const float c_r = cr[(d * 16 + co) * 64 + p], c_i = ci[(d * 16 + co) * 64 + p], p_r = pwr[(d * 64 + p) * 17 + j], p_i = pwi[(d * 64 + p) * 17 + j];
            const float gr = c_r * p_r - c_i * p_i, gi = c_r * p_i + c_i * p_r; s += gr * bbr[(d * 64 + p) * 16 + cin] - gi * bbi[(d * 64 + p) * 16 + cin]; }
        klag[i] = s; }
    __syncthreads();
    bf16_t* Bc = (bf16_t*)(a.ws + WS_BCAT + (size_t)l * BCAT_BYTES) + (size_t)g * 256 * 512;
    bf16_t* Em = (bf16_t*)(a.ws + WS_E + (size_t)l * E_BYTES) + (size_t)g * 256 * 256;
    const float* Dv = a.in[I_S5D] + ((size_t)l * 16 + g) * 16;
    for (int i = tid; i < 256 * 256; i += NTHR) { const int n = i >> 8, k2 = (i & 255) * 2; const int t = n >> 4, co = n & 15; float v[2];
#pragma unroll
        for (int e = 0; e < 2; ++e) { const int k = k2 + e;
            if (k < 256) { const int s = k >> 4, cin = k & 15; float x = 0.f;
                if (s <= t) x += klag[((0 * 16 + (t - s)) * 16 + co) * 16 + cin];
                if (s >= t) x += klag[((1 * 16 + (s - t)) * 16 + co) * 16 + cin];
                if (s == t && cin == co) x += Dv[co];
                v[e] = x; }
            else { const int kk = k - 256, d = kk >> 7, p = (kk >> 1) & 63, ri = kk & 1, pe = d == 0 ? t + 1 : 16 - t;
                const float c_r = cr[(d * 16 + co) * 64 + p], c_i = ci[(d * 16 + co) * 64 + p], p_r = pwr[(d * 64 + p) * 17 + pe], p_i = pwi[(d * 64 + p) * 17 + pe];
                v[e] = ri == 0 ? (c_r * p_r - c_i * p_i) : -(c_r * p_i + c_i * p_r); } }
        *(unsigned*)(Bc + (size_t)n * 512 + k2) = cvtpk(v[0], v[1]); }
    for (int i = tid; i < 256 * 128; i += NTHR) { const int n = i >> 7, k2 = (i & 127) * 2; const int d = n >> 7, p = (n >> 1) & 63, ri = n & 1; float v[2];
#pragma unroll
        for (int e = 0; e < 2; ++e) { const int k = k2 + e, s = k >> 4, cin = k & 15, pe = d == 0 ? 15 - s : s;
            const float p_r = pwr[(d * 64 + p) * 17 + pe], p_i = pwi[(d * 64 + p) * 17 + pe], b_r = bbr[(d * 64 + p) * 16 + cin], b_i = bbi[(d * 64 + p) * 16 + cin];
            v[e] = ri == 0 ? (p_r * b_r - p_i * b_i) : (p_r * b_i + p_i * b_r); }
        *(unsigned*)(Em + (size_t)n * 256 + k2) = cvtpk(v[0], v[1]); }
    __syncthreads();
}
__device__ __forceinline__ void phase0(const Args& a, LAS unsigned char* lds, int tid, int wave, int lane) {
    const int b = blockIdx.x, G = gridDim.x;
    for (int it = b; it < 144; it += G) adaln_item(a, lds, it, tid);
    for (int it = (b + G - 144 % G) % G; it < 32; it += G) s5gen_item(a, lds, it, tid);
    if (b == G - 1) { const int pos = tid >> 3, i = tid & 7; const float inv = exp2f(-(float)i * 0.125f * 13.287712379549449f); float s, c; sincos_rev((float)pos * inv, s, c);
        float* rt = (float*)(a.ws + WS_ROPE); rt[(pos * 8 + i) * 2 + 0] = c; rt[(pos * 8 + i) * 2 + 1] = s; }
    __syncthreads();
    convert_weights(a, lds, b * NWAVES + wave, G * NWAVES, wave, lane);
}

__device__ __forceinline__ const float* xrow_ptr(const Args& a, int l, int m) {
    if (l == 0) return m < TC ? a.in[I_XP] + (size_t)m * DM : a.in[I_XS] + (size_t)(m - TC) * DM;
    return a.out + (size_t)m * DM;
}
__device__ __forceinline__ void norm_phase(const Args& a, int l, int j, bool src_inputs, int gw, int ngw, int lane) {
    const float* nw = a.in[I_NORMW] + ((size_t)l * 3 + j) * DM;
    bf16_t* XN = (bf16_t*)(a.ws + WS_XN);
    for (int m = gw; m < T; m += ngw) {
        const float* xr = src_inputs ? xrow_ptr(a, 0, m) : a.out + (size_t)m * DM;
        const int cond = m < TC ? 0 : 1 + ((m - TC) >> 11);
        const float* md = (const float*)(a.ws + WS_MOD) + ((size_t)l * 5 + cond) * 9216 + (size_t)(3 * j) * DM;
        f32x4 v[4]; float ss = 0.f;
#pragma unroll
        for (int q = 0; q < 4; ++q) { v[q] = ((const f32x4*)xr)[lane + 64 * q]; ss += (v[q].x * v[q].x + v[q].y * v[q].y) + (v[q].z * v[q].z + v[q].w * v[q].w); }
        const float rinv = __builtin_amdgcn_rsqf(wave_sum(ss, lane) * (1.0f / DM) + EPS);
#pragma unroll
        for (int q = 0; q < 4; ++q) { const int ix = lane + 64 * q; const f32x4 w = ((const f32x4*)nw)[ix], sh = ((const f32x4*)md)[ix], sc = ((const f32x4*)(md + DM))[ix];
            const f32x4 y = v[q] * rinv * w * (sc + 1.0f) + sh;
            u32x2 o; o.x = cvtpk(y.x, y.y); o.y = cvtpk(y.z, y.w); ((u32x2*)(XN + (size_t)m * DM))[ix] = o; }
    }
}
__device__ __forceinline__ void final_norm_phase(const Args& a, int gw, int ngw, int lane) {
    const float* nw = a.in[I_FNW];
    for (int m = gw; m < T; m += ngw) { float* xr = a.out + (size_t)m * DM; f32x4 v[4]; float ss = 0.f;
#pragma unroll
        for (int q = 0; q < 4; ++q) { v[q] = ((const f32x4*)xr)[lane + 64 * q]; ss += (v[q].x * v[q].x + v[q].y * v[q].y) + (v[q].z * v[q].z + v[q].w * v[q].w); }
        const float rinv = __builtin_amdgcn_rsqf(wave_sum(ss, lane) * (1.0f / DM) + EPS);
#pragma unroll
        for (int q = 0; q < 4; ++q) { const int ix = lane + 64 * q; ((f32x4*)xr)[ix] = v[q] * rinv * ((const f32x4*)nw)[ix]; } }
}

#define XB_TMO      128
#define XB_XCNT(j)  (256  + 64 * (j))
#define XB_XSUB(j)  (1280 + 64 * (j))
#define XB_XGEN(j)  (2304 + 64 * (j))
#define XB_TOP      3328
#define XB_TOPGEN   3392
#define XCD_BAR_WORDS 3456
#define XB_SPIN_CAP (1u << 18)

__device__ __forceinline__ unsigned xb_ld(unsigned* p)              { return __hip_atomic_load(p, __ATOMIC_RELAXED, __HIP_MEMORY_SCOPE_AGENT); }
__device__ __forceinline__ unsigned xb_add(unsigned* p, unsigned v) { return __hip_atomic_fetch_add(p, v, __ATOMIC_RELAXED, __HIP_MEMORY_SCOPE_AGENT); }
__device__ __forceinline__ unsigned xb_xcc_id() { return (unsigned)__builtin_amdgcn_s_getreg((3 << 11) | 20) & 0xFu; }
#define XB_SPIN(cond, bar) do { unsigned _sp = 0; while (cond) { __builtin_amdgcn_s_sleep(1); \
    if ((++_sp & 255u) == 0u) { if (xb_ld(&(bar)[XB_TMO])) break; if (_sp > XB_SPIN_CAP) { atomicAdd(&(bar)[XB_TMO], 1u); break; } } } } while (0)

struct XcdBarrier {
    unsigned* bar; unsigned x;
    volatile LAS unsigned* st;
};

__device__ __forceinline__ XcdBarrier xcd_barrier_post(unsigned* bar, volatile LAS unsigned* st, bool leader) {
    XcdBarrier b; b.bar = bar; b.x = xb_xcc_id(); b.st = st;
    if (leader) (void)xb_add(&bar[XB_XCNT(b.x)], 1u);
    return b;
}
__device__ __forceinline__ void xcd_barrier_complete(unsigned* bar, unsigned x, unsigned& nloc, unsigned& nx) {
    const unsigned G = gridDim.x * gridDim.y * gridDim.z;
    unsigned sum, cnt, mine, sp = 0u;
    for (;;) {
        sum = 0u; cnt = 0u; mine = 0u;
#pragma unroll
        for (unsigned j = 0; j < 16; ++j) { const unsigned c = xb_ld(&bar[XB_XCNT(j)]); sum += c; cnt += (c > 0u) ? 1u : 0u; mine = (j == x) ? c : mine; }
        if (sum == G) break;
        __builtin_amdgcn_s_sleep(1);
        if ((++sp & 255u) == 0u) { if (xb_ld(&bar[XB_TMO])) break; if (sp > XB_SPIN_CAP) { atomicAdd(&bar[XB_TMO], 1u); break; } }
    }
    nloc = mine > 0u ? mine : 1u; nx = cnt > 0u ? cnt : 1u;
}

__device__ __forceinline__ void xcd_barrier(const XcdBarrier& b, bool leader) {
    asm volatile("s_waitcnt vmcnt(0)" ::: "memory");
    __syncthreads();
    if (leader) {
        unsigned* bar = b.bar;
        __builtin_amdgcn_s_waitcnt(0);
        unsigned nloc = b.st[0], nx = b.st[1];
        if (nloc == 0u) { xcd_barrier_complete(bar, b.x, nloc, nx); b.st[0] = nloc; b.st[1] = nx; }
        const unsigned old = xb_add(&bar[XB_XSUB(b.x)], 1u);
        const unsigned gen = old / nloc;
        if (old + 1u == (gen + 1u) * nloc) {
            __builtin_amdgcn_fence(__ATOMIC_RELEASE, "agent");
            asm volatile("s_waitcnt vmcnt(0)" ::: "memory");
            const unsigned og = xb_add(&bar[XB_TOP], 1u);
            const unsigned tg = og / nx;
            if (og + 1u == (tg + 1u) * nx) xb_add(&bar[XB_TOPGEN], 1u);
            else XB_SPIN(xb_ld(&bar[XB_TOPGEN]) == tg, bar);
            __builtin_amdgcn_fence(__ATOMIC_ACQUIRE, "agent");
            xb_add(&bar[XB_XGEN(b.x)], 1u);
            asm volatile("s_waitcnt vmcnt(0)" ::: "memory");
        } else {
            XB_SPIN(xb_ld(&bar[XB_XGEN(b.x)]) == gen, bar);
            __builtin_amdgcn_fence(__ATOMIC_ACQUIRE, "agent");
            asm volatile("s_waitcnt vmcnt(0)" ::: "memory");
        }
    }
    __syncthreads();
}

__device__ __forceinline__ void post_phase(const Args& a, int l, int gw, int ngw, int lane) {
    unsigned char* ws = a.ws;
    const bf16_t* P = (const bf16_t*)(ws + WS_P);
    bf16_t* QD = (bf16_t*)(ws + WS_QD); bf16_t* KD = (bf16_t*)(ws + WS_KD); bf16_t* VD = (bf16_t*)(ws + WS_VD);
    bf16_t* CQN = (bf16_t*)(ws + WS_CQN); bf16_t* CKVN = (bf16_t*)(ws + WS_CKVN); bf16_t* KPE = (bf16_t*)(ws + WS_KPE); bf16_t* A2 = (bf16_t*)(ws + WS_A2);
    const float* rope = (const float*)(ws + WS_ROPE);
    const float* qnw = a.in[I_QNW] + (size_t)l * 256; const float* kvnw = a.in[I_KVNW] + (size_t)l * 128;
    const float QS = 0.17677669529663687f * 1.4426950408889634f;
    for (int m = gw; m < T + 1024; m += ngw) {
        if (m >= T) {
            const int r = m - T, b = r >> 8, s = r & 255; const size_t kr = 8192 + (size_t)b * 2304 + 2048 + s;
            const size_t src = ((size_t)(b * 2 + l) * 256 + s);
            const float* ck = a.in[I_CDK] + src * 384; const float* cv = a.in[I_CDV] + src * 384;
#pragma unroll
            for (int q = 0; q < 3; ++q) { const int j = 2 * (lane + 64 * q);
                *(unsigned*)(KD + kr * 384 + j) = cvtpk(ck[j], ck[j + 1]); *(unsigned*)(VD + kr * 384 + j) = cvtpk(cv[j], cv[j + 1]); }
            const float* cc = a.in[I_CCKV] + src * 128; *(unsigned*)(CKVN + kr * 256 + 2 * lane) = cvtpk(cc[2 * lane], cc[2 * lane + 1]); *(unsigned*)(CKVN + kr * 256 + 128 + 2 * lane) = 0u;
            if (lane < 16) { const float* cp = a.in[I_CKPE] + src * 32; *(unsigned*)(KPE + kr * 32 + 2 * lane) = cvtpk(cp[2 * lane], cp[2 * lane + 1]); }
            continue;
        }
        const bool lat = m >= TC;
        int b = 0, t = 0; if (lat) { b = (m - TC) >> 11; t = (m - TC) & 2047; }
        const size_t kr = lat ? 8192 + (size_t)b * 2304 + t : (size_t)m;
        const int prow = t >> 6, pcol = t & 63;
        const size_t orow = ((size_t)((m >> 8) * 2 + l) * 256 + (m & 255));
        const u32x4* pr = (const u32x4*)(P + (size_t)m * 2048);
#pragma unroll
        for (int i = 0; i < 4; ++i) {
            const int c = lane + 64 * i;
            const u32x4 raw = pr[c];
            float v[8], pv[8]; unpack8(raw, v);
#pragma unroll
            for (int e = 0; e < 8; ++e) pv[e] = shx(v[e], 1, lane);
            float rv[8];
            { const int pos = (c & 2) ? pcol : prow; const f32x4* rp = (const f32x4*)(rope + pos * 16);
#pragma unroll
              for (int e2 = 0; e2 < 4; ++e2) { f32x4 cs = rp[e2];
                  if (!lat) cs = (f32x4){1.0f, 0.0f, 1.0f, 0.0f};
                  if (c & 1) { rv[2 * e2] = pv[2 * e2] * cs.y + v[2 * e2] * cs.x; rv[2 * e2 + 1] = pv[2 * e2 + 1] * cs.w + v[2 * e2 + 1] * cs.z; }
                  else       { rv[2 * e2] = v[2 * e2] * cs.x - pv[2 * e2] * cs.y; rv[2 * e2 + 1] = v[2 * e2 + 1] * cs.z - pv[2 * e2 + 1] * cs.w; } } }
            float ssq = 0.f, sskv = 0.f;
            if (i == 2) { float s = 0.f;
#pragma unroll
                for (int e = 0; e < 8; ++e) s += v[e] * v[e];
                ssq = wave_sum((lane >= 16 && lane < 48) ? s : 0.f, lane); sskv = wave_sum(lane >= 48 ? s : 0.f, lane); }
            if (c < 48) {
                float o[8];
#pragma unroll
                for (int e = 0; e < 8; ++e) o[e] = rv[e] * QS;
                *(u32x4*)(QD + (size_t)m * 384 + 8 * c) = pack8(o);
            } else if (c < 96) {
                const int cs = c - 48;
                *(u32x4*)(KD + kr * 384 + 8 * cs) = pack8(rv);
                if (!lat) { float* o = a.out + OUT_DK + orow * 384 + 8 * cs;
                       *(f32x4*)o = (f32x4){v[0], v[1], v[2], v[3]}; *(f32x4*)(o + 4) = (f32x4){v[4], v[5], v[6], v[7]}; }
            } else if (c < 144) {
                const int cs = c - 96;
                *(u32x4*)(VD + kr * 384 + 8 * cs) = raw;
                if (!lat) { float* o = a.out + OUT_DV + orow * 384 + 8 * cs; *(f32x4*)o = (f32x4){v[0], v[1], v[2], v[3]}; *(f32x4*)(o + 4) = (f32x4){v[4], v[5], v[6], v[7]}; }
            } else if (c < 176) {
                const int cs = c - 144; const float rinv = __builtin_amdgcn_rsqf(ssq * (1.0f / 256.0f) + EPS); float o[8];
#pragma unroll
                for (int e = 0; e < 8; ++e) o[e] = v[e] * rinv * qnw[8 * cs + e];
                *(u32x4*)(CQN + (size_t)m * 256 + 8 * cs) = pack8(o);
            } else if (c < 192) {
                const int cs = c - 176; const float rinv = __builtin_amdgcn_rsqf(sskv * (1.0f / 128.0f) + EPS); float o[8];
#pragma unroll
                for (int e = 0; e < 8; ++e) o[e] = v[e] * rinv * kvnw[8 * cs + e];
                *(u32x4*)(CKVN + kr * 256 + 8 * cs) = pack8(o); { unsigned z = 0u; asm volatile("" : "+v"(z)); *(u32x4*)(CKVN + kr * 256 + 128 + 8 * cs) = (u32x4){z, z, z, z}; }
                if (!lat) { float* op = a.out + OUT_CKV + orow * 128 + 8 * cs; *(f32x4*)op = (f32x4){o[0], o[1], o[2], o[3]}; *(f32x4*)(op + 4) = (f32x4){o[4], o[5], o[6], o[7]}; }
            } else if (c < 196) {
                const int cs = c - 192;
                *(u32x4*)(KPE + kr * 32 + 8 * cs) = pack8(rv);
                if (!lat) { float* op = a.out + OUT_KPE + orow * 32 + 8 * cs;
                       *(f32x4*)op = (f32x4){v[0], v[1], v[2], v[3]}; *(f32x4*)(op + 4) = (f32x4){v[4], v[5], v[6], v[7]}; }
            } else if (c < 228) {
                const int cs = c - 196, g = cs >> 1;
                *(u32x4*)(A2 + ((size_t)g * 1024 + (m >> 4)) * 512 + (m & 15) * 16 + (cs & 1) * 8) = raw;
            }
        }
    }
}

__device__ __forceinline__ void s5_combine_phase(const Args& a, int l, int gw, int ngw, int lane) {
    const float* S = (const float*)(a.ws + WS_S); bf16_t* A2 = (bf16_t*)(a.ws + WS_A2);
    for (int w = gw; w < 36 * 32; w += ngw) {
        const int seq = w >> 5, g = (w >> 1) & 15, d = w & 1, p = lane;
        const size_t ix = (((size_t)l * 2 + d) * 16 + g) * 64 + p;
        const float are = a.in[I_ARE][ix], aim = a.in[I_AIM][ix], st = __expf(a.in[I_LSTEP][((size_t)l * 2 + d) * 16 + g]);
        const float mag = __expf(16.0f * are * st); float sn, cs; sincos_rev(16.0f * aim * st, sn, cs);
        const float lr = mag * cs, li = mag * sn;
        const bool lat = seq >= 32; const int nch = lat ? 128 : 16; const int row0 = lat ? 512 + (seq - 32) * 128 : seq * 16;
        float hr = 0.f, hi = 0.f;
        if (lat) { const size_t six = ((((size_t)(seq - 32) * 2 + l) * 2 + d) * 16 + g) * 64 + p; hr = a.in[I_SRE][six]; hi = a.in[I_SIM][six]; }
        for (int cc = 0; cc < nch; ++cc) { const int ch = d == 0 ? cc : nch - 1 - cc; const size_t row = (size_t)g * 1024 + row0 + ch;
            *(unsigned*)(A2 + row * 512 + 256 + d * 128 + 2 * p) = cvtpk(hr, hi);
            const f32x2_t s = *(const f32x2_t*)(S + row * 256 + d * 128 + 2 * p);
            const float nr = lr * hr - li * hi + s.x, ni = lr * hi + li * hr + s.y; hr = nr; hi = ni; }
        if (!lat) { const size_t oix = ((((size_t)seq * 2 + l) * 2 + d) * 16 + g) * 64 + p; a.out[OUT_SRE + oix] = hr; a.out[OUT_SIM + oix] = hi; }
    }
}

struct AttnState { float m, l; f32x16 o[2]; };
__device__ __forceinline__ bf16x8 vfrag(const LAS bf16_t* vb) {
    typedef short v4i16_t __attribute__((ext_vector_type(4)));
    const s16x4 lo = __builtin_bit_cast(s16x4, __builtin_amdgcn_ds_read_tr16_b64_v4i16((LAS v4i16_t*)vb));
    const s16x4 hi = __builtin_bit_cast(s16x4, __builtin_amdgcn_ds_read_tr16_b64_v4i16((LAS v4i16_t*)(vb + 256)));
    return (bf16x8){lo[0], lo[1], lo[2], lo[3], hi[0], hi[1], hi[2], hi[3]};
}
template <int NK>
__device__ __forceinline__ void attn_tile(AttnState& st, const LAS bf16_t* Kl, int kstr, int koff, const bf16x8* qf, const LAS bf16_t* vrd, int lane) {
    const int r32 = lane & 31, hi = lane >> 5;
    f32x16 s0, s1;
#pragma unroll
    for (int e = 0; e < 16; ++e) { s0[e] = 0.f; s1[e] = 0.f; }
    const LAS bf16_t* kp = Kl + r32 * kstr + koff + 8 * hi;
#pragma unroll
    for (int ks = 0; ks < NK; ++ks) {
        const bf16x8 k0 = *(const LAS bf16x8*)(kp + 16 * ks), k1 = *(const LAS bf16x8*)(kp + 32 * kstr + 16 * ks);
        s0 = __builtin_amdgcn_mfma_f32_32x32x16_bf16(k0, qf[ks], s0, 0, 0, 0);
        s1 = __builtin_amdgcn_mfma_f32_32x32x16_bf16(k1, qf[ks], s1, 0, 0, 0);
    }
    float mx = s0[0];
#pragma unroll
    for (int e = 1; e < 16; ++e) mx = fmaxf(mx, s0[e]);
#pragma unroll
    for (int e = 0; e < 16; ++e) mx = fmaxf(mx, s1[e]);
    mx = fmaxf(mx, shx(mx, 32, lane));
    const float mnew = fmaxf(st.m, mx), alpha = __builtin_amdgcn_exp2f(st.m - mnew); st.m = mnew;
    float rs = 0.f;
#pragma unroll
    for (int e = 0; e < 16; ++e) { s0[e] = __builtin_amdgcn_exp2f(s0[e] - mnew); s1[e] = __builtin_amdgcn_exp2f(s1[e] - mnew); rs += s0[e] + s1[e]; }
    st.l = st.l * alpha + rs;
#pragma unroll
    for (int e = 0; e < 16; ++e) { st.o[0][e] *= alpha; st.o[1][e] *= alpha; }
    bf16x8 pb[2][2];
#pragma unroll
    for (int s = 0; s < 2; ++s) {
        u32x4 w0; w0.x = cvtpk(s0[8 * s + 0], s0[8 * s + 1]); w0.y = cvtpk(s0[8 * s + 2], s0[8 * s + 3]); w0.z = cvtpk(s0[8 * s + 4], s0[8 * s + 5]); w0.w = cvtpk(s0[8 * s + 6], s0[8 * s + 7]);
        u32x4 w1; w1.x = cvtpk(s1[8 * s + 0], s1[8 * s + 1]); w1.y = cvtpk(s1[8 * s + 2], s1[8 * s + 3]); w1.z = cvtpk(s1[8 * s + 4], s1[8 * s + 5]); w1.w = cvtpk(s1[8 * s + 6], s1[8 * s + 7]);
        pb[0][s] = __builtin_bit_cast(bf16x8, w0); pb[1][s] = __builtin_bit_cast(bf16x8, w1);
    }
#pragma unroll
    for (int db = 0; db < 2; ++db)
#pragma unroll
        for (int kb = 0; kb < 2; ++kb)
#pragma unroll
            for (int s = 0; s < 2; ++s) st.o[db] = __builtin_amdgcn_mfma_f32_32x32x16_bf16(vfrag(vrd + db * 2048 + (32 * kb + 16 * s) * 32), pb[kb][s], st.o[db], 0, 0, 0);
}
template <int MODE>
__device__ __forceinline__ void attn_item(const Args& a, LAS unsigned char* lds, int l, int ksp, int h, int qt, float lam, float lam_init, int tid, int wave, int lane) {
    constexpr int KSTR = MODE == 0 ? 72 : 104;
    unsigned char* ws = a.ws;
    LAS bf16_t* Kl = (LAS bf16_t*)lds; LAS bf16_t* Vl = (LAS bf16_t*)(lds + 13312);
    const bool lat = ksp >= 32;
    const int nt = lat ? 36 : 4;
    const size_t keyrow0 = lat ? 8192 + (size_t)(ksp - 32) * 2304 : (size_t)ksp * 256;
    const int qrow0 = lat ? TC + (ksp - 32) * 2048 + qt * 256 : ksp * 256;
    const int r32 = lane & 31, hi = lane >> 5;
    const int qrow = qrow0 + 32 * wave + r32;
    const bf16_t* Ksrc; const bf16_t* Vsrc; const bf16_t* Psrc = nullptr; int kvs;
    if (MODE == 0) { Ksrc = (const bf16_t*)(ws + WS_KD) + keyrow0 * 384 + h * 64; Vsrc = (const bf16_t*)(ws + WS_VD) + keyrow0 * 384 + h * 64; kvs = 384; }
    else { Ksrc = (const bf16_t*)(ws + WS_KV) + keyrow0 * 768 + h * 128; Vsrc = Ksrc + 64; Psrc = (const bf16_t*)(ws + WS_KPE) + keyrow0 * 32; kvs = 768; }
    constexpr int NQF = MODE == 0 ? 4 : 6;
    bf16x8 qf[NQF];
    if (MODE == 0) { const bf16_t* qp = (const bf16_t*)(ws + WS_QD) + (size_t)qrow * 384 + h * 64 + 8 * hi;
#pragma unroll
        for (int f = 0; f < 4; ++f) qf[f] = *(const bf16x8*)(qp + 16 * f); }
    else { const float QS1 = 0.10206207261596577f * 1.4426950408889634f;
        const bf16_t* qp = (const bf16_t*)(ws + WS_Q2) + (size_t)qrow * 768 + h * 96;
        const int t = (qrow - TC) & 2047; const float* rope = (const float*)(ws + WS_ROPE);
#pragma unroll
        for (int f = 0; f < 6; ++f) { float o[8];
            if (f < 4) { float v[8]; unpack8(*(const u32x4*)(qp + 16 * f + 8 * hi), v);
#pragma unroll
                for (int e = 0; e < 8; ++e) o[e] = v[e] * QS1; }
            else { float x1[8], x2[8]; unpack8(*(const u32x4*)(qp + 16 * f), x1); unpack8(*(const u32x4*)(qp + 16 * f + 8), x2);
                const int pos = f == 4 ? (t >> 6) : (t & 63); const float* rp = rope + pos * 16;
#pragma unroll
                for (int e = 0; e < 8; ++e) { const float cs = lat ? rp[2 * e] : 1.0f, sn = lat ? rp[2 * e + 1] : 0.0f;
                    o[e] = (hi == 0 ? x1[e] * cs - x2[e] * sn : x1[e] * sn + x2[e] * cs) * QS1; } }
            qf[f] = __builtin_bit_cast(bf16x8, pack8(o)); } }
    AttnState st0, st1;
    st0.m = -1e30f; st0.l = 0.f; st1.m = -1e30f; st1.l = 0.f;
#pragma unroll
    for (int e = 0; e < 16; ++e) { st0.o[0][e] = 0.f; st0.o[1][e] = 0.f; st1.o[0][e] = 0.f; st1.o[1][e] = 0.f; }
    const int key = tid >> 3, ch = tid & 7;
    const bf16_t* kg = Ksrc + (size_t)key * kvs + 8 * ch; const bf16_t* vg = Vsrc + (size_t)key * kvs + 8 * ch;
    const bf16_t* pg = MODE == 1 ? Psrc + (size_t)(tid >> 2) * 32 + 8 * (tid & 3) : nullptr;
    LAS bf16_t* kl = Kl + key * KSTR + 8 * ch; LAS bf16_t* vl = Vl + (ch >> 2) * 2048 + key * 32 + 8 * (ch & 3);
    LAS bf16_t* pl = Kl + (tid >> 2) * KSTR + 64 + 8 * (tid & 3);
    u32x4 kreg = *(const u32x4*)kg, vreg = *(const u32x4*)vg, preg;
    if (MODE == 1) preg = *(const u32x4*)(tid < 256 ? pg : kg);
    const LAS bf16_t* vrd = Vl + (4 * hi + ((lane & 15) >> 2)) * 32 + 16 * ((lane >> 4) & 1) + 4 * (lane & 3);
    for (int kt = 0; kt < nt; ++kt) {
        __syncthreads();
        *(LAS u32x4*)kl = kreg; *(LAS u32x4*)vl = vreg; if (MODE == 1 && tid < 256) *(LAS u32x4*)pl = preg;
        __syncthreads();
        if (kt + 1 < nt) { const size_t adv = (size_t)(kt + 1) * 64; kreg = *(const u32x4*)(kg + adv * kvs); vreg = *(const u32x4*)(vg + adv * kvs); if (MODE == 1) preg = *(const u32x4*)(tid < 256 ? pg + adv * 32 : kg); }
        if (MODE == 0) { attn_tile<2>(st0, Kl, KSTR, 0, qf, vrd, lane); attn_tile<2>(st1, Kl, KSTR, 32, qf + 2, vrd, lane); }
        else attn_tile<6>(st0, Kl, KSTR, 0, qf, vrd, lane);
    }
    bf16_t* Ob = (bf16_t*)(ws + WS_XN) + (size_t)qrow * 1024 + (MODE == 0 ? 0 : 384) + h * 64;
    const float l0 = st0.l + shx(st0.l, 32, lane); const float i0 = 1.0f / l0;
    float o[2][16];
    if (MODE == 0) {
        const float l1 = st1.l + shx(st1.l, 32, lane); const float i1 = lam / l1; float ss = 0.f;
#pragma unroll
        for (int db = 0; db < 2; ++db)
#pragma unroll
            for (int e = 0; e < 16; ++e) { const float v = st0.o[db][e] * i0 - st1.o[db][e] * i1; o[db][e] = v; ss += v * v; }
        ss += shx(ss, 32, lane);
        const float rinv = __builtin_amdgcn_rsqf(ss * (1.0f / 64.0f) + EPS) * (1.0f - lam_init);
        const float* sw = a.in[I_SUBLN] + (size_t)l * 64;
#pragma unroll
        for (int db = 0; db < 2; ++db)
#pragma unroll
            for (int e = 0; e < 16; ++e) o[db][e] *= rinv * sw[32 * db + (e & 3) + 8 * (e >> 2) + 4 * hi];
    } else {
#pragma unroll
        for (int db = 0; db < 2; ++db)
#pragma unroll
            for (int e = 0; e < 16; ++e) o[db][e] = st0.o[db][e] * i0;
    }
#pragma unroll
    for (int db = 0; db < 2; ++db)
#pragma unroll
        for (int rg = 0; rg < 4; ++rg) { u32x2 w; w.x = cvtpk(o[db][4 * rg], o[db][4 * rg + 1]); w.y = cvtpk(o[db][4 * rg + 2], o[db][4 * rg + 3]);
            *(u32x2*)(Ob + 32 * db + 8 * rg + 4 * hi) = w; }
}

__global__ void __launch_bounds__(NTHR, 2) mega_fwd(Args a) {
    extern __shared__ __attribute__((aligned(16))) unsigned char lds_raw[];
    LAS unsigned char* lds0 = (LAS unsigned char*)lds_raw;
    LAS unsigned char* lds = lds0 + 1024;
    cg::grid_group grid = cg::this_grid();
    const int G = gridDim.x, bx = blockIdx.x, ngw = G * NWAVES;
    const int wave0 = __builtin_amdgcn_readfirstlane((int)threadIdx.x >> 6);
    ArgTab tab = (ArgTab)lds0;
    if (threadIdx.x == 0) {
#pragma unroll
        for (int i = 0; i < 34; ++i) tab[i] = (unsigned long long)a.in[i];
        tab[34] = (unsigned long long)a.out; tab[35] = (unsigned long long)a.ws;
    }
    if (threadIdx.x < 2) ((LAS unsigned*)(lds0 + 512))[threadIdx.x] = 0u;
    __syncthreads();
    (void)xcd_barrier_post((unsigned*)(a.ws + WS_CTL) + CW_BAR, (volatile LAS unsigned*)(lds0 + 512), threadIdx.x == 0);
#define PH_BEGIN LAS unsigned char* tb_ = lds0; asm volatile("" : "+v"(tb_)); const Args b = load_args((ArgTab)tb_); int tid = wave0 * 64 + (int)__builtin_amdgcn_mbcnt_hi(~0u, __builtin_amdgcn_mbcnt_lo(~0u, 0u)); asm volatile("" : "+v"(tid)); const int lane = tid & 63, wave = __builtin_amdgcn_readfirstlane(tid >> 6), gw = bx * NWAVES + wave; unsigned char* ws = b.ws; (void)lane; (void)gw; (void)ws;
#define GSYNC() do { PH_BEGIN XcdBarrier bb_; bb_.bar = (unsigned*)(ws + WS_CTL) + CW_BAR; bb_.x = xb_xcc_id(); bb_.st = (volatile LAS unsigned*)(lds0 + 512); xcd_barrier(bb_, tid == 0); } while (0)
    { PH_BEGIN phase0(b, lds, tid, wave, lane); }
    grid.sync();
    for (int l = 0; l < 2; ++l) {
        { PH_BEGIN norm_phase(b, l, 0, l == 0, gw, ngw, lane); }
        GSYNC();
        { PH_BEGIN pg8::Gemm g{(const bf16_t*)(ws + WS_XN), (const bf16_t*)(ws + WS_W1 + (size_t)(l * 2 + 0) * W1_BYTES), T, 5632, 1024, 1024, 1024}; pg8::StaticOrder S; S.init(T, 5632, G, bx);
          pg8::EpiSwiglu E{(bf16_t*)(ws + WS_H)}; pg8::gemm_phase<pg8::EpiSwiglu, pg8::StaticOrder, true, true>(lds, g, S, E, tid); }
        GSYNC();
        { PH_BEGIN pg8::Gemm g{(const bf16_t*)(ws + WS_H), (const bf16_t*)(ws + WS_W2 + (size_t)(l * 2 + 0) * W2_BYTES), T, 1024, 2816, 2816, 2816}; pg8::StaticOrder S; S.init(T, 1024, G, bx);
          pg8::EpiResid E{l == 0 ? b.in[I_XP] : b.out, l == 0 ? b.in[I_XS] : b.out + (size_t)TC * DM, b.out, (const float*)(ws + WS_MOD) + (size_t)l * 5 * 9216 + 2 * DM, 0.5f};
          pg8::gemm_phase<pg8::EpiResid, pg8::StaticOrder, true, true>(lds, g, S, E, tid); }
        GSYNC();
        { PH_BEGIN norm_phase(b, l, 1, false, gw, ngw, lane); }
        GSYNC();
        { PH_BEGIN pg8::Gemm g{(const bf16_t*)(ws + WS_XN), (const bf16_t*)(ws + WS_WIN + (size_t)l * WIN_BYTES), T, 2048, 1024, 1024, 1024}; pg8::StaticOrder S; S.init(T, 2048, G, bx);
          pg8::EpiBf16 E{(bf16_t*)(ws + WS_P), 2048}; pg8::gemm_phase<pg8::EpiBf16, pg8::StaticOrder, true, true>(lds, g, S, E, tid); }
        GSYNC();
        { PH_BEGIN post_phase(b, l, gw, ngw, lane); }
        GSYNC();
        { PH_BEGIN pg8::Gemm g{(const bf16_t*)(ws + WS_CQN), (const bf16_t*)(ws + WS_WQ + (size_t)l * WQ_BYTES), T, 768, 256, 256, 256}; pg8::StaticOrder S; S.init(T, 768, G, bx);
          pg8::EpiBf16 E{(bf16_t*)(ws + WS_Q2), 768}; pg8::gemm_phase<pg8::EpiBf16, pg8::StaticOrder, true, true>(lds, g, S, E, tid); }
        { PH_BEGIN pg8::Gemm g{(const bf16_t*)(ws + WS_CKVN), (const bf16_t*)(ws + WS_WKV + (size_t)l * WKV_BYTES), KR, 768, 256, 256, 256}; pg8::StaticOrder S; S.init(KR, 768, G, (bx + 64) % G);
          pg8::EpiBf16 E{(bf16_t*)(ws + WS_KV), 768}; pg8::gemm_phase<pg8::EpiBf16, pg8::StaticOrder, true, true>(lds, g, S, E, tid); }
        { PH_BEGIN pg8::Gemm g{(const bf16_t*)(ws + WS_A2), (const bf16_t*)(ws + WS_E + (size_t)l * E_BYTES), 16384, 4096, 256, 512, 256}; pg8::GroupOrder S{64, G, (bx + 116) % G};
          pg8::EpiS5State E{(float*)(ws + WS_S)}; pg8::gemm_phase<pg8::EpiS5State, pg8::GroupOrder, true, true>(lds, g, S, E, tid); }
        GSYNC();
        { PH_BEGIN s5_combine_phase(b, l, gw, ngw, lane); }
        GSYNC();
        { PH_BEGIN pg8::Gemm g{(const bf16_t*)(ws + WS_A2), (const bf16_t*)(ws + WS_BCAT + (size_t)l * BCAT_BYTES), 16384, 4096, 512, 512, 512}; pg8::GroupOrder S{64, G, bx};
          pg8::EpiS5Y E{(bf16_t*)(ws + WS_CQN)}; pg8::gemm_phase<pg8::EpiS5Y, pg8::GroupOrder, true, true>(lds, g, S, E, tid); }
        {
            PH_BEGIN
            unsigned* ctl = (unsigned*)(ws + WS_CTL);
            const float lam_init = 0.8f - 0.6f * __expf(-0.3f * (float)l);
            const float* lp = b.in[I_DLAM] + (size_t)l * 128;
            float pr = lane < 32 ? lp[lane] * lp[32 + lane] : lp[64 + lane - 32] * lp[96 + lane - 32];
#pragma unroll
            for (int o = 1; o < 32; o <<= 1) pr += shx(pr, o, lane);
            const float lam = __expf(__builtin_bit_cast(float, __builtin_amdgcn_readlane(__builtin_bit_cast(int, pr), 0))) - __expf(__builtin_bit_cast(float, __builtin_amdgcn_readlane(__builtin_bit_cast(int, pr), 32))) + lam_init;
            volatile LAS int* qslot = (volatile LAS int*)(lds + 24576);
            for (;;) {
                __syncthreads();
                if (tid == 0) *qslot = (int)atomicAdd(ctl + CW_Q + 64 * l, 1u);
                __syncthreads();
                const int it = *qslot;
                if (it >= 384) break;
                const bool heavy = it < 192; const int j = heavy ? it : it - 192;
                attn_item<0>(b, lds, l, heavy ? 32 + j / 48 : j / 6, heavy ? (j % 48) >> 3 : j % 6, heavy ? (j & 7) : 0, lam, lam_init, tid, wave, lane);
            }
        }
        {
            PH_BEGIN
            unsigned* ctl = (unsigned*)(ws + WS_CTL);
            volatile LAS int* qslot = (volatile LAS int*)(lds + 24576);
            for (;;) {
                __syncthreads();
                if (tid == 0) *qslot = (int)atomicAdd(ctl + CW_Q + 64 * (2 + l), 1u);
                __syncthreads();
                const int it = *qslot;
                if (it >= 384) break;
                const bool heavy = it < 192; const int j = heavy ? it : it - 192;
                attn_item<1>(b, lds, l, heavy ? 32 + j / 48 : j / 6, heavy ? (j % 48) >> 3 : j % 6, heavy ? (j & 7) : 0, 0.f, 0.f, tid, wave, lane);
            }
        }
        GSYNC();
        { PH_BEGIN pg8::Gemm g{(const bf16_t*)(ws + WS_CQN), (const bf16_t*)(ws + WS_WGLU + (size_t)l * WGLU_BYTES), T, 256, 256, 256, 256}; pg8::StaticOrder S; S.init(T, 256, G, bx);
          pg8::EpiGlu E{(const bf16_t*)(ws + WS_CQN), b.in[I_BGLU] + (size_t)l * 256, (bf16_t*)(ws + WS_XN)}; pg8::gemm_phase<pg8::EpiGlu, pg8::StaticOrder, true, true>(lds, g, S, E, tid); }
        GSYNC();
        { PH_BEGIN pg8::Gemm g{(const bf16_t*)(ws + WS_XN), (const bf16_t*)(ws + WS_WOUT + (size_t)l * WOUT_BYTES), T, 1024, 1024, 1024, 1024}; pg8::StaticOrder S; S.init(T, 1024, G, bx);
          pg8::EpiResid E{b.out, b.out + (size_t)TC * DM, b.out, (const float*)(ws + WS_MOD) + (size_t)l * 5 * 9216 + 5 * DM, 1.0f};
          pg8::gemm_phase<pg8::EpiResid, pg8::StaticOrder, true, true>(lds, g, S, E, tid); }
        GSYNC();
        { PH_BEGIN norm_phase(b, l, 2, false, gw, ngw, lane); }
        GSYNC();
        { PH_BEGIN pg8::Gemm g{(const bf16_t*)(ws + WS_XN), (const bf16_t*)(ws + WS_W1 + (size_t)(l * 2 + 1) * W1_BYTES), T, 5632, 1024, 1024, 1024}; pg8::StaticOrder S; S.init(T, 5632, G, bx);
          pg8::EpiSwiglu E{(bf16_t*)(ws + WS_H)}; pg8::gemm_phase<pg8::EpiSwiglu, pg8::StaticOrder, true, true>(lds, g, S, E, tid); }
        GSYNC();
        { PH_BEGIN pg8::Gemm g{(const bf16_t*)(ws + WS_H), (const bf16_t*)(ws + WS_W2 + (size_t)(l * 2 + 1) * W2_BYTES), T, 1024, 2816, 2816, 2816}; pg8::StaticOrder S; S.init(T, 1024, G, bx);
          pg8::EpiResid E{b.out, b.out + (size_t)TC * DM, b.out, (const float*)(ws + WS_MOD) + (size_t)l * 5 * 9216 + 8 * DM, 0.5f};
          pg8::gemm_phase<pg8::EpiResid, pg8::StaticOrder, true, true>(lds, g, S, E, tid); }
        GSYNC();
    }
    { PH_BEGIN final_norm_phase(b, gw, ngw, lane); }
}

extern "C" void kernel_launch(void* const* d_in, const int* in_sizes, int n_in, void* d_out, int out_size, void* d_ws, size_t ws_size, hipStream_t stream) {
    static int grid = 0;
    if (grid == 0) {
        if (n_in != 34 || ws_size < WS_END) { fprintf(stderr, "kernel_launch: expected 34 inputs and >= %zu bytes of workspace; got %d, %zu\n", (size_t)WS_END, n_in, ws_size); grid = -1; return; }
        int dev = 0, cus = 0, per_cu = 0;
        if (hipGetDevice(&dev) != hipSuccess || hipDeviceGetAttribute(&cus, hipDeviceAttributeMultiprocessorCount, dev) != hipSuccess) { grid = -1; return; }
        if (hipFuncSetAttribute((const void*)mega_fwd, hipFuncAttributeMaxDynamicSharedMemorySize, LDS_BYTES) != hipSuccess) { fprintf(stderr, "kernel_launch: hipFuncSetAttribute failed\n"); grid = -1; return; }
        if (hipOccupancyMaxActiveBlocksPerMultiprocessor(&per_cu, (const void*)mega_fwd, NTHR, LDS_BYTES) != hipSuccess || per_cu < 1) { fprintf(stderr, "kernel_launch: occupancy query reports %d\n", per_cu); per_cu = 1; }
        (void)hipGetLastError();
        grid = cus * 1;
    }
    if (grid < 0) return;
    (void)hipMemsetAsync((char*)d_ws + WS_CTL, 0, CTL_BYTES, stream);
    Args a{};
    for (int i = 0; i < 34; ++i) a.in[i] = (const float*)d_in[i];
    a.out = (float*)d_out; a.ws = (unsigned char*)d_ws;
    void* params[] = {&a};
    hipError_t e = hipLaunchCooperativeKernel((const void*)mega_fwd, dim3(grid), dim3(NTHR), params, LDS_BYTES, stream);
    if (e != hipSuccess) fprintf(stderr, "cooperative launch failed: %s (grid %d)\n", hipGetErrorString(e), grid);
}
```

```cpp
#include <hip/hip_runtime.h>
#include <hip/hip_cooperative_groups.h>
#include <cstdio>
#include <cstdint>
namespace cg = cooperative_groups;

namespace pg8 {
#define PG8_LAS __attribute__((address_space(3)))
typedef unsigned short bf16_t;
typedef short bf16x8 __attribute__((ext_vector_type(8)));
typedef float f32x4 __attribute__((ext_vector_type(4)));
typedef unsigned u32x4 __attribute__((ext_vector_type(4)));
constexpr int BM = 256, BK = 64, HALF = 128, HTB = HALF * BK * 2  , STAGE_BYTES = 8 * HTB, NXCD = 8, WGM = 8;

__host__ __device__ __forceinline__ int lds_byte(int r, int c) { const int st = (r >> 4) * 2 + (c >> 5), rr = r & 15, cc = c & 31, ob = rr * 64 + cc * 2; return st * 1024 + (ob ^ (((ob >> 9) & 1) << 5)); }
__host__ __device__ __forceinline__ void stage_rc(int b, int& R, int& C) { const int st = b / 1024, sb = b % 1024, swz = sb ^ (((sb >> 9) & 1) << 5); R = (st >> 1) * 16 + swz / 64; C = (st & 1) * 32 + (swz % 64) / 2; }
__host__ __device__ __forceinline__ int perm32(int rho) { const int n = rho >> 4, i = rho & 15; return 8 * (i >> 2) + 4 * n + (i & 3); }

struct Unit { int pm, pn; };
struct Gemm { const bf16_t* A; const bf16_t* Bt; int M, N, K, lda, ldb; };

struct StaticOrder {
    int nM, nN, nwg, G, c;
    __host__ __device__ void init(int M, int N, int G_, int c_) { nM = M / BM; nN = N / BM; nwg = nM * nN; G = G_; c = c_; }
    __host__ __device__ bool next(int i, Unit& u) const {
        const long L = (long)i * G + c; if (L >= nwg) return false;
        int wgid = (int)L; { const int q = nwg / NXCD, r = nwg % NXCD, xcd = wgid % NXCD, off = wgid / NXCD; wgid = (xcd < r ? xcd * (q + 1) : r * (q + 1) + (xcd - r) * q) + off; }
        const int nig = WGM * nN, gid = wgid / nig, fm = gid * WGM, gsz = (nM - fm) < WGM ? (nM - fm) : WGM;
        u.pm = fm + ((wgid % nig) % gsz); u.pn = (wgid % nig) / gsz; return true;
    }
    __device__ __forceinline__ void a_ready(const Unit&) const {}
    __device__ __forceinline__ void done(const Unit&) const {}
};
struct GroupOrder {
    int n, G, c;
    __device__ bool next(int i, Unit& u) const { const int L = i * G + c; if (L >= n) return false; u.pm = L; u.pn = L >> 2; return true; }
    __device__ __forceinline__ void a_ready(const Unit&) const {}
    __device__ __forceinline__ void done(const Unit&) const {}
};
__device__ __forceinline__ unsigned cvt_pk_bf16(float lo, float hi) { unsigned r; asm volatile("v_cvt_pk_bf16_f32 %0, %1, %2" : "=v"(r) : "v"(lo), "v"(hi)); return r; }
__device__ __forceinline__ float fsigmoid(float z) { return __builtin_amdgcn_rcpf(1.0f + __expf(-z)); }
struct EpiBf16 {
    static constexpr bool PERM = true, AFTER_DRAIN = false;
    bf16_t* O; int ldc;
    __device__ __forceinline__ void operator()(const f32x4 (&acc)[2][2][4][2], const Unit& u, int wr, int wc, int fr, int fq) const {
        const int row0 = u.pm * BM + wr * 64 + fr; const int col0 = u.pn * BM + wc * 32 + 8 * fq;
#pragma unroll
        for (int ai = 0; ai < 2; ++ai)
#pragma unroll
            for (int m = 0; m < 4; ++m) { bf16_t* rowp = O + (size_t)(row0 + ai * HALF + m * 16) * ldc + col0;
#pragma unroll
                for (int bj = 0; bj < 2; ++bj) { const f32x4 v0 = acc[ai][bj][m][0], v1 = acc[ai][bj][m][1];
                    u32x4 w; w.x = cvt_pk_bf16(v0[0], v0[1]); w.y = cvt_pk_bf16(v0[2], v0[3]); w.z = cvt_pk_bf16(v1[0], v1[1]); w.w = cvt_pk_bf16(v1[2], v1[3]);
                    *(u32x4*)(rowp + bj * HALF) = w; } }
    }
};
struct EpiSwiglu {
    static constexpr bool PERM = true, AFTER_DRAIN = false;
    bf16_t* H;
    __device__ __forceinline__ void operator()(const f32x4 (&acc)[2][2][4][2], const Unit& u, int wr, int wc, int fr, int fq) const {
        const int row0 = u.pm * BM + wr * 64 + fr; const int col0 = u.pn * HALF + wc * 32 + 8 * fq;
#pragma unroll
        for (int ai = 0; ai < 2; ++ai)
#pragma unroll
            for (int m = 0; m < 4; ++m) { bf16_t* rowp = H + (size_t)(row0 + ai * HALF + m * 16) * 2816 + col0;
                float h[8];
#pragma unroll
                for (int n = 0; n < 2; ++n) { const f32x4 av = acc[ai][0][m][n], gv = acc[ai][1][m][n];
#pragma unroll
                    for (int e = 0; e < 4; ++e) h[4 * n + e] = av[e] * gv[e] * fsigmoid(gv[e]); }
                u32x4 w; w.x = cvt_pk_bf16(h[0], h[1]); w.y = cvt_pk_bf16(h[2], h[3]); w.z = cvt_pk_bf16(h[4], h[5]); w.w = cvt_pk_bf16(h[6], h[7]);
                *(u32x4*)rowp = w; }
    }
};
struct EpiResid {
    static constexpr bool PERM = false, AFTER_DRAIN = false;
    const float* resA; const float* resB; float* out; const float* gate; float gs;
    __device__ __forceinline__ void operator()(const f32x4 (&acc)[2][2][4][2], const Unit& u, int wr, int wc, int fr, int fq) const {
        const int row0 = u.pm * BM + wr * 64 + fr; const int col0 = u.pn * BM + wc * 32 + 4 * fq;
        const int cond = (u.pm < 32) ? 0 : 1 + ((u.pm - 32) >> 3);
        const float* gp = gate + (size_t)cond * 9216 + col0;
        f32x4 gv[2][2];
#pragma unroll
        for (int bj = 0; bj < 2; ++bj)
#pragma unroll
            for (int n = 0; n < 2; ++n) gv[bj][n] = *(const f32x4*)(gp + bj * HALF + n * 16) * gs;
#pragma unroll
        for (int ai = 0; ai < 2; ++ai)
#pragma unroll
            for (int m = 0; m < 4; ++m) { const int row = row0 + ai * HALF + m * 16;
                const float* rp = (row < 8192 ? resA + (size_t)row * 1024 : resB + (size_t)(row - 8192) * 1024) + col0; float* op = out + (size_t)row * 1024 + col0;
#pragma unroll
                for (int bj = 0; bj < 2; ++bj)
#pragma unroll
                    for (int n = 0; n < 2; ++n) { const f32x4 r = *(const f32x4*)(rp + bj * HALF + n * 16); *(f32x4*)(op + bj * HALF + n * 16) = r + gv[bj][n] * acc[ai][bj][m][n]; } }
    }
};
struct EpiS5State {
    static constexpr bool PERM = false, AFTER_DRAIN = false;
    float* S;
    __device__ __forceinline__ void operator()(const f32x4 (&acc)[2][2][4][2], const Unit& u, int wr, int wc, int fr, int fq) const {
        const int row0 = u.pm * BM + wr * 64 + fr; const int col0 = wc * 32 + 4 * fq;
#pragma unroll
        for (int ai = 0; ai < 2; ++ai)
#pragma unroll
            for (int m = 0; m < 4; ++m) { float* op = S + (size_t)(row0 + ai * HALF + m * 16) * 256 + col0;
#pragma unroll
                for (int bj = 0; bj < 2; ++bj)
#pragma unroll
                    for (int n = 0; n < 2; ++n) *(f32x4*)(op + bj * HALF + n * 16) = acc[ai][bj][m][n]; }
    }
};
__device__ __forceinline__ float gelu_tanh(float x) { const float z = 1.5957691216f * (x + 0.044715f * x * x * x); return x * fsigmoid(z); }
struct EpiS5Y {
    static constexpr bool PERM = true, AFTER_DRAIN = false;
    bf16_t* YG;
    __device__ __forceinline__ void operator()(const f32x4 (&acc)[2][2][4][2], const Unit& u, int wr, int wc, int fr, int fq) const {
        const int row0 = (u.pm & 3) * BM + wr * 64 + fr; const int g = u.pn;
#pragma unroll
        for (int ai = 0; ai < 2; ++ai)
#pragma unroll
            for (int m = 0; m < 4; ++m) { const int rloc = row0 + ai * HALF + m * 16;
#pragma unroll
                for (int bj = 0; bj < 2; ++bj) { const int j = bj * HALF + wc * 32 + 8 * fq; const int tok = rloc * 16 + (j >> 4);
                    const f32x4 v0 = acc[ai][bj][m][0], v1 = acc[ai][bj][m][1];
                    u32x4 w; w.x = cvt_pk_bf16(gelu_tanh(v0[0]), gelu_tanh(v0[1])); w.y = cvt_pk_bf16(gelu_tanh(v0[2]), gelu_tanh(v0[3]));
                    w.z = cvt_pk_bf16(gelu_tanh(v1[0]), gelu_tanh(v1[1])); w.w = cvt_pk_bf16(gelu_tanh(v1[2]), gelu_tanh(v1[3]));
                    *(u32x4*)(YG + (size_t)tok * 256 + g * 16 + (j & 15)) = w; } }
    }
};
struct EpiGlu {
    static constexpr bool PERM = true, AFTER_DRAIN = false;
    const bf16_t* YG; const float* bias; bf16_t* O;
    __device__ __forceinline__ void operator()(const f32x4 (&acc)[2][2][4][2], const Unit& u, int wr, int wc, int fr, int fq) const {
        const int row0 = u.pm * BM + wr * 64 + fr; const int col0 = wc * 32 + 8 * fq;
#pragma unroll
        for (int ai = 0; ai < 2; ++ai)
#pragma unroll
            for (int m = 0; m < 4; ++m) { const int row = row0 + ai * HALF + m * 16;
#pragma unroll
                for (int bj = 0; bj < 2; ++bj) { const int col = col0 + bj * HALF;
                    const u32x4 y = *(const u32x4*)(YG + (size_t)row * 256 + col);
                    const f32x4 b0 = *(const f32x4*)(bias + col), b1 = *(const f32x4*)(bias + col + 4);
                    const f32x4 v0 = acc[ai][bj][m][0] + b0, v1 = acc[ai][bj][m][1] + b1;
                    float yy[8]; yy[0] = __uint_as_float(y.x << 16); yy[1] = __uint_as_float(y.x & 0xffff0000u); yy[2] = __uint_as_float(y.y << 16); yy[3] = __uint_as_float(y.y & 0xffff0000u);
                    yy[4] = __uint_as_float(y.z << 16); yy[5] = __uint_as_float(y.z & 0xffff0000u); yy[6] = __uint_as_float(y.w << 16); yy[7] = __uint_as_float(y.w & 0xffff0000u);
                    u32x4 w; w.x = cvt_pk_bf16(yy[0] * fsigmoid(v0[0]), yy[1] * fsigmoid(v0[1])); w.y = cvt_pk_bf16(yy[2] * fsigmoid(v0[2]), yy[3] * fsigmoid(v0[3]));
                    w.z = cvt_pk_bf16(yy[4] * fsigmoid(v1[0]), yy[5] * fsigmoid(v1[1])); w.w = cvt_pk_bf16(yy[6] * fsigmoid(v1[2]), yy[7] * fsigmoid(v1[3]));
                    *(u32x4*)(O + (size_t)row * 1024 + 768 + col) = w; asm volatile("" ::: "memory"); } }
    }
};

template <class Epi, class Sched, bool ALIGN_EPI = false, bool SP2 = false>
__device__ __forceinline__ void gemm_phase(PG8_LAS unsigned char* lds, const Gemm g, const Sched& S, const Epi& E, int tid_in) {
    int tid_ = tid_in; asm volatile("" : "+v"(tid_));
    const int tid = tid_, wid = __builtin_amdgcn_readfirstlane(tid >> 6), lane = tid & 63, wr = wid >> 2, wc = wid & 3, fr = lane & 15, fq = lane >> 4;
    int K_ = g.K; asm volatile("" : "+s"(K_));
    const int K = K_, nt = K / BK;
    unsigned voffA[2], voffB[2];
#pragma unroll
    for (int i = 0; i < 2; ++i) { int R, C; stage_rc(tid * 16 + i * 8192, R, C); const int Rb = Epi::PERM ? ((R & ~31) + perm32(R & 31)) : R;
        voffA[i] = (unsigned)(R * g.lda + C) * 2u; voffB[i] = (unsigned)(Rb * g.ldb + C) * 2u; }
    const size_t kstep = (size_t)(BK * 2);
    const size_t hsA = (size_t)HALF * g.lda * 2, hsB = (size_t)HALF * g.ldb * 2;
    const size_t tsA = 2 * hsA, tsB = 2 * hsB;
    const unsigned ldsw = (unsigned)wid * 1024u;
    const int aoff = lds_byte(wr * 64 + fr, fq * 8), boff = lds_byte(wc * 32 + fr, fq * 8);
#define PG8_SA(b, h) (((b) * 2 + (h)) * HTB)
#define PG8_SB(b, h) ((4 + (b) * 2 + (h)) * HTB)
#define PG8_STAGE(bufoff, gbase, voff) do { _Pragma("unroll") for (int _i = 0; _i < 2; ++_i) \
        __builtin_amdgcn_global_load_lds((const unsigned*)((const char*)(gbase) + (voff)[_i]), (PG8_LAS unsigned*)(lds + (bufoff) + ldsw + _i * 8192), 16, 0, 0); } while (0)
#define PG8_LDA(dst, b, h) do { _Pragma("unroll") for (int m = 0; m < 4; ++m) _Pragma("unroll") for (int k = 0; k < 2; ++k) dst[m][k] = *(const PG8_LAS bf16x8*)(lds + PG8_SA(b, h) + aoff + m * 2048 + k * 1024); } while (0)
#define PG8_LDB(dst, b, h) do { _Pragma("unroll") for (int n = 0; n < 2; ++n) _Pragma("unroll") for (int k = 0; k < 2; ++k) dst[n][k] = *(const PG8_LAS bf16x8*)(lds + PG8_SB(b, h) + boff + n * 2048 + k * 1024); } while (0)
#define PG8_MMA(ai, bj, At, Bt) do { __builtin_amdgcn_s_setprio(1); _Pragma("unroll") for (int m = 0; m < 4; ++m) _Pragma("unroll") for (int n = 0; n < 2; ++n) _Pragma("unroll") for (int k = 0; k < 2; ++k) \
        acc[ai][bj][m][n] = __builtin_amdgcn_mfma_f32_16x16x32_bf16(Bt[n][k], At[m][k], acc[ai][bj][m][n], 0, 0, 0); __builtin_amdgcn_s_setprio(0); } while (0)
#define PG8_WAIT_V(n) asm volatile("s_waitcnt vmcnt(" #n ")" ::: "memory")
#define PG8_WAIT_L(n) asm volatile("s_waitcnt lgkmcnt(" #n ")" ::: "memory")
#define PG8_BAR __builtin_amdgcn_s_barrier()
#define PG8_SCHED __builtin_amdgcn_sched_barrier(0)
    Unit cur, nxt; int ui = 0;
    if (!S.next(0, cur)) return;
    f32x4 acc[2][2][4][2];
#pragma unroll
    for (int a = 0; a < 2; ++a)
#pragma unroll
        for (int b = 0; b < 2; ++b)
#pragma unroll
            for (int m = 0; m < 4; ++m)
#pragma unroll
                for (int n = 0; n < 2; ++n) acc[a][b][m][n] = (f32x4){0.f, 0.f, 0.f, 0.f};
    bf16x8 At[4][2], B0[2][2], B1[2][2];
    const char* cA = (const char*)g.A + (size_t)cur.pm * tsA; const char* cB = (const char*)g.Bt + (size_t)cur.pn * tsB;
    S.a_ready(cur);
    if constexpr (SP2) {
        PG8_STAGE(PG8_SB(0, 0), cB, voffB); PG8_STAGE(PG8_SB(0, 1), cB + hsB, voffB); PG8_STAGE(PG8_SA(0, 0), cA, voffA); PG8_STAGE(PG8_SA(0, 1), cA + hsA, voffA);
        if (wr == 1) PG8_BAR;
        PG8_WAIT_V(2); PG8_BAR;
        PG8_STAGE(PG8_SB(1, 0), cB + kstep, voffB); PG8_STAGE(PG8_SA(1, 0), cA + kstep, voffA); PG8_STAGE(PG8_SB(1, 1), cB + hsB + kstep, voffB);
        PG8_WAIT_V(6); PG8_BAR;
    } else {
        PG8_STAGE(PG8_SB(0, 0), cB, voffB); PG8_STAGE(PG8_SA(0, 0), cA, voffA); PG8_STAGE(PG8_SB(0, 1), cB + hsB, voffB); PG8_STAGE(PG8_SA(0, 1), cA + hsA, voffA);
        if (wr == 1) PG8_BAR;
        PG8_WAIT_V(4); PG8_BAR;
        PG8_STAGE(PG8_SB(1, 0), cB + kstep, voffB); PG8_STAGE(PG8_SA(1, 0), cA + kstep, voffA); PG8_STAGE(PG8_SB(1, 1), cB + hsB + kstep, voffB);
        PG8_WAIT_V(6); PG8_BAR;
    }
    for (;;) {
        const bool has_next = S.next(ui + 1, nxt);
        const char* nA = has_next ? (const char*)g.A + (size_t)nxt.pm * tsA : cA; const char* nB = has_next ? (const char*)g.Bt + (size_t)nxt.pn * tsB : cB;
        for (int t = 0; t < nt; t += 2) {
            const bool last = (t == nt - 2);
            const char* a1 = cA + (size_t)(t + 1) * kstep;
            const char* a2 = last ? nA : cA + (size_t)(t + 2) * kstep; const char* b2 = last ? nB : cB + (size_t)(t + 2) * kstep;
            const char* a3 = a2 + kstep; const char* b3 = b2 + kstep;
            if (last && has_next) S.a_ready(nxt);
            if constexpr (SP2) {
            PG8_LDB(B0, 0, 0); PG8_LDB(B1, 0, 1); PG8_SCHED; PG8_LDA(At, 0, 0); PG8_STAGE(PG8_SA(1, 1), a1 + hsA, voffA);
            PG8_WAIT_V(8); PG8_WAIT_L(0); PG8_BAR; PG8_MMA(0, 0, At, B0); PG8_MMA(0, 1, At, B1); PG8_BAR; PG8_SCHED;
            PG8_LDA(At, 0, 1); PG8_STAGE(PG8_SB(0, 0), b2, voffB); PG8_STAGE(PG8_SB(0, 1), b2 + hsB, voffB); PG8_STAGE(PG8_SA(0, 0), a2, voffA);
            PG8_WAIT_V(8); PG8_WAIT_L(0); PG8_BAR; PG8_MMA(1, 0, At, B0); PG8_MMA(1, 1, At, B1); PG8_BAR; PG8_SCHED;
            PG8_LDB(B0, 1, 0); PG8_LDB(B1, 1, 1); PG8_SCHED; PG8_LDA(At, 1, 0); PG8_STAGE(PG8_SA(0, 1), a2 + hsA, voffA);
            PG8_WAIT_V(8); PG8_WAIT_L(0); PG8_BAR; PG8_MMA(0, 0, At, B0); PG8_MMA(0, 1, At, B1); PG8_BAR; PG8_SCHED;
            PG8_LDA(At, 1, 1); PG8_STAGE(PG8_SB(1, 0), b3, voffB); PG8_STAGE(PG8_SB(1, 1), b3 + hsB, voffB); PG8_STAGE(PG8_SA(1, 0), a3, voffA);
            PG8_WAIT_V(8); PG8_WAIT_L(0); PG8_BAR; PG8_MMA(1, 0, At, B0); PG8_MMA(1, 1, At, B1); PG8_BAR; PG8_SCHED;
            } else {
            PG8_LDB(B0, 0, 0); PG8_SCHED; PG8_LDA(At, 0, 0); PG8_STAGE(PG8_SA(1, 1), a1 + hsA, voffA);
            PG8_WAIT_L(8); PG8_BAR; PG8_WAIT_L(0); PG8_MMA(0, 0, At, B0); PG8_BAR; PG8_SCHED;
            PG8_LDB(B1, 0, 1); PG8_STAGE(PG8_SB(0, 0), b2, voffB);
            PG8_BAR; PG8_WAIT_L(0); PG8_MMA(0, 1, At, B1); PG8_BAR;
            PG8_LDA(At, 0, 1); PG8_STAGE(PG8_SA(0, 0), a2, voffA);
            PG8_BAR; PG8_WAIT_L(0); PG8_MMA(1, 0, At, B0); PG8_BAR; PG8_SCHED;
            PG8_STAGE(PG8_SB(0, 1), b2 + hsB, voffB);
            PG8_WAIT_V(6); PG8_BAR; PG8_MMA(1, 1, At, B1); PG8_BAR;
            PG8_LDB(B0, 1, 0); PG8_SCHED; PG8_LDA(At, 1, 0); PG8_STAGE(PG8_SA(0, 1), a2 + hsA, voffA);
            PG8_WAIT_L(8); PG8_BAR; PG8_WAIT_L(0); PG8_MMA(0, 0, At, B0); PG8_BAR; PG8_SCHED;
            PG8_LDB(B1, 1, 1); PG8_STAGE(PG8_SB(1, 0), b3, voffB);
            PG8_BAR; PG8_WAIT_L(0); PG8_MMA(0, 1, At, B1); PG8_BAR;
            PG8_LDA(At, 1, 1); PG8_STAGE(PG8_SA(1, 0), a3, voffA);
            PG8_BAR; PG8_WAIT_L(0); PG8_MMA(1, 0, At, B0); PG8_BAR; PG8_SCHED;
            PG8_STAGE(PG8_SB(1, 1), b3 + hsB, voffB);
            PG8_WAIT_V(6); PG8_BAR; PG8_MMA(1, 1, At, B1); PG8_BAR;
            }
        }
        if constexpr (ALIGN_EPI) { if (wr == 0) PG8_BAR; }
        if constexpr (!Epi::AFTER_DRAIN) { E(acc, cur, wr, wc, fr, fq); S.done(cur); }
        if (!has_next) break;
#pragma unroll
        for (int a = 0; a < 2; ++a)
#pragma unroll
            for (int b = 0; b < 2; ++b)
#pragma unroll
                for (int m = 0; m < 4; ++m)
#pragma unroll
                    for (int n = 0; n < 2; ++n) acc[a][b][m][n] = (f32x4){0.f, 0.f, 0.f, 0.f};
        cur = nxt; cA = nA; cB = nB; ++ui;
        if constexpr (ALIGN_EPI) { if (wr == 1) PG8_BAR; }
    }
    PG8_WAIT_V(0);
    if constexpr (!ALIGN_EPI) { if (wr == 0) PG8_BAR; }
    PG8_BAR;
    if constexpr (Epi::AFTER_DRAIN) { E.fused(acc, cur, wr, wc, fr, fq, lds, wid, lane); S.done(cur); }
#undef PG8_SA
#undef PG8_SB
#undef PG8_STAGE
#undef PG8_LDA
#undef PG8_LDB
#undef PG8_MMA
#undef PG8_WAIT_V
#undef PG8_WAIT_L
#undef PG8_BAR
#undef PG8_SCHED
}
}

#define LAS __attribute__((address_space(3)))
typedef unsigned short bf16_t;
typedef short bf16x8 __attribute__((ext_vector_type(8)));
typedef short s16x4 __attribute__((ext_vector_type(4)));
typedef float f32x4 __attribute__((ext_vector_type(4)));
typedef float f32x16 __attribute__((ext_vector_type(16)));
typedef unsigned u32x4 __attribute__((ext_vector_type(4)));
typedef unsigned u32x2 __attribute__((ext_vector_type(2)));
typedef float f32x2_t __attribute__((ext_vector_type(2)));
typedef __bf16 bf16x2_t __attribute__((ext_vector_type(2)));

constexpr int T = 16384, TC = 8192, DM = 1024, FF = 2816, KR = 17408;
constexpr int NTHR = 512, NWAVES = 8;
constexpr float EPS = 1e-6f;
constexpr size_t MiB = 1u << 20;
constexpr size_t WS_CTL = 0, CTL_BYTES = 32768;
constexpr size_t WS_MOD = 1 * MiB;
constexpr size_t WS_ROPE = 1 * MiB + 512 * 1024;
constexpr size_t WS_W1 = 2 * MiB, W1_BYTES = (size_t)5632 * 1024 * 2;
constexpr size_t WS_W2 = 46 * MiB, W2_BYTES = (size_t)1024 * 2816 * 2;
constexpr size_t WS_WIN = 68 * MiB, WIN_BYTES = (size_t)2048 * 1024 * 2;
constexpr size_t WS_WOUT = 76 * MiB, WOUT_BYTES = (size_t)1024 * 1024 * 2;
constexpr size_t WS_WQ = 80 * MiB, WQ_BYTES = (size_t)768 * 256 * 2;
constexpr size_t WS_WKV = WS_WQ + 2 * WQ_BYTES, WKV_BYTES = (size_t)768 * 256 * 2;
constexpr size_t WS_WGLU = WS_WKV + 2 * WKV_BYTES, WGLU_BYTES = (size_t)256 * 256 * 2;
constexpr size_t WS_BCAT = 82 * MiB, BCAT_BYTES = (size_t)16 * 256 * 512 * 2;
constexpr size_t WS_E = 90 * MiB, E_BYTES = (size_t)16 * 256 * 256 * 2;
constexpr size_t WS_XN = 94 * MiB;
constexpr size_t WS_H = 126 * MiB;
constexpr size_t WS_P = 126 * MiB;
constexpr size_t WS_Q2 = 126 * MiB;
constexpr size_t WS_KV = 150 * MiB;
constexpr size_t WS_QD = 190 * MiB;
constexpr size_t WS_KD = 214 * MiB;
constexpr size_t WS_VD = 227 * MiB;
constexpr size_t WS_CQN = 240 * MiB;
constexpr size_t WS_CKVN = 248 * MiB;
constexpr size_t WS_KPE = 257 * MiB;
constexpr size_t WS_A2 = 259 * MiB;
constexpr size_t WS_S = 275 * MiB;
constexpr size_t WS_END = 291 * MiB;
constexpr int CW_BAR = 1024;
constexpr int CW_Q = 64;
constexpr int LDS_BYTES = 147456;
constexpr size_t OUT_DK = 16777216, OUT_DV = 23068672, OUT_CKV = 29360128, OUT_KPE = 31457280, OUT_SRE = 31981568, OUT_SIM = 32112640;

struct Args { const float* in[34]; float* out; unsigned char* ws; };
enum { I_XP = 0, I_XS, I_CDK, I_CDV, I_CCKV, I_CKPE, I_SRE, I_SIM, I_C, I_CCTX, I_WADA, I_BADA, I_NORMW, I_FFNIN, I_FFNOUT, I_WIN, I_DLAM, I_SUBLN, I_QNW, I_WQUP, I_KVNW, I_WKVUP,
       I_ARE, I_AIM, I_LSTEP, I_BRE, I_BIM, I_CRE, I_CIM, I_S5D, I_WGLU, I_BGLU, I_WOUT, I_FNW };

typedef volatile LAS unsigned long long* ArgTab;
__device__ __forceinline__ unsigned long long ldarg(ArgTab t, int i) { const unsigned long long v = t[i]; const unsigned lo = __builtin_amdgcn_readfirstlane((unsigned)v), hi = __builtin_amdgcn_readfirstlane((unsigned)(v >> 32)); return ((unsigned long long)hi << 32) | lo; }
__device__ __forceinline__ Args load_args(ArgTab t) { Args b;
#pragma unroll
    for (int i = 0; i < 34; ++i) b.in[i] = (const float*)ldarg(t, i);
    b.out = (float*)ldarg(t, 34); b.ws = (unsigned char*)ldarg(t, 35); return b; }
#define LDS_WAIT() asm volatile("s_waitcnt lgkmcnt(0)" ::: "memory")
__device__ __forceinline__ unsigned cvtpk(float lo, float hi) { f32x2_t v = {lo, hi}; bf16x2_t b = __builtin_convertvector(v, bf16x2_t); return __builtin_bit_cast(unsigned, b); }
__device__ __forceinline__ float bflo(unsigned w) { return __uint_as_float(w << 16); }
__device__ __forceinline__ float bfhi(unsigned w) { return __uint_as_float(w & 0xffff0000u); }
__device__ __forceinline__ float shx(float v, int o, int lane) { return __builtin_bit_cast(float, __builtin_amdgcn_ds_bpermute((lane ^ o) << 2, __builtin_bit_cast(int, v))); }
__device__ __forceinline__ float wave_sum(float v, int lane) {
#pragma unroll
    for (int o = 1; o < 64; o <<= 1) v += shx(v, o, lane);
    return v;
}
__device__ __forceinline__ void sincos_rev(float ang, float& s, float& c) {
    float rev = ang * 0.15915494309189535f; rev -= floorf(rev);
    s = __builtin_amdgcn_sinf(rev); c = __builtin_amdgcn_cosf(rev);
}
__device__ __forceinline__ void unpack8(const u32x4 r, float (&v)[8]) {
    v[0] = bflo(r.x); v[1] = bfhi(r.x); v[2] = bflo(r.y); v[3] = bfhi(r.y); v[4] = bflo(r.z); v[5] = bfhi(r.z); v[6] = bflo(r.w); v[7] = bfhi(r.w);
}
__device__ __forceinline__ u32x4 pack8(const float (&v)[8]) { u32x4 w; w.x = cvtpk(v[0], v[1]); w.y = cvtpk(v[2], v[3]); w.z = cvtpk(v[4], v[5]); w.w = cvtpk(v[6], v[7]); return w; }

__device__ __forceinline__ void transpose_item(const float* W, int ldw, int k0, int nsrc0, bf16_t* WT, int ldt, int ndst0, LAS float* scr, int lane) {
    const int kr = lane >> 3, nq = lane & 7;
    f32x4 v[8];
#pragma unroll
    for (int i = 0; i < 8; ++i) v[i] = *(const f32x4*)(W + (size_t)(k0 + 8 * i + kr) * ldw + nsrc0 + 4 * nq);
#pragma unroll
    for (int i = 0; i < 8; ++i) { LAS float* d = scr + (8 * i + kr) * 33 + 4 * nq; d[0] = v[i].x; d[1] = v[i].y; d[2] = v[i].z; d[3] = v[i].w; }
    LDS_WAIT(); asm volatile("" ::: "memory");
    const int c = lane & 7;
#pragma unroll
    for (int j = 0; j < 4; ++j) { const int n = (lane >> 3) + 8 * j; const LAS float* s = scr + (8 * c) * 33 + n;
        u32x4 o; o.x = cvtpk(s[0 * 33], s[1 * 33]); o.y = cvtpk(s[2 * 33], s[3 * 33]); o.z = cvtpk(s[4 * 33], s[5 * 33]); o.w = cvtpk(s[6 * 33], s[7 * 33]);
        *(u32x4*)(WT + (size_t)(ndst0 + n) * ldt + k0 + 8 * c) = o; }
    LDS_WAIT(); asm volatile("" ::: "memory");
}
__device__ __forceinline__ void convert_weights(const Args& a, LAS unsigned char* lds, int gw, int ngw, int wave, int lane) {
    LAS float* scr = (LAS float*)(lds + wave * 16384);
    unsigned char* ws = a.ws;
    constexpr int I_1 = 16 * 176, I_2 = 44 * 32, I_IN = 16 * 57, I_O = 16 * 32, I_Q = 4 * 18, I_KV = 2 * 24, I_G = 4 * 8;
    constexpr int NITEMS = 4 * I_1 + 4 * I_2 + 2 * I_IN + 2 * I_O + 2 * I_Q + 2 * I_KV + 2 * I_G;
    for (int it = gw; it < NITEMS; it += ngw) {
        int r = it;
        if (r < 4 * I_1) { const int mi = r / I_1, q = r % I_1, kb = q / 176, nb = q % 176, nd = nb * 32;
            const int ns = ((nd >> 7) & 1) * 2816 + (nd >> 8) * 128 + (nd & 127);
            transpose_item(a.in[I_FFNIN] + (size_t)mi * 1024 * 5632, 5632, kb * 64, ns, (bf16_t*)(ws + WS_W1 + mi * W1_BYTES), 1024, nd, scr, lane); continue; }
        r -= 4 * I_1;
        if (r < 4 * I_2) { const int mi = r / I_2, q = r % I_2, kb = q / 32, nb = q % 32;
            transpose_item(a.in[I_FFNOUT] + (size_t)mi * 2816 * 1024, 1024, kb * 64, nb * 32, (bf16_t*)(ws + WS_W2 + mi * W2_BYTES), 2816, nb * 32, scr, lane); continue; }
        r -= 4 * I_2;
        if (r < 2 * I_IN) { const int mi = r / I_IN, q = r % I_IN, kb = q / 57, nb = q % 57;
            transpose_item(a.in[I_WIN] + (size_t)mi * 1024 * 1824, 1824, kb * 64, nb * 32, (bf16_t*)(ws + WS_WIN + mi * WIN_BYTES), 1024, nb * 32, scr, lane); continue; }
        r -= 2 * I_IN;
        if (r < 2 * I_O) { const int mi = r / I_O, q = r % I_O, kb = q / 32, nb = q % 32;
            transpose_item(a.in[I_WOUT] + (size_t)mi * 1024 * 1024, 1024, kb * 64, nb * 32, (bf16_t*)(ws + WS_WOUT + mi * WOUT_BYTES), 1024, nb * 32, scr, lane); continue; }
        r -= 2 * I_O;
        if (r < 2 * I_Q) { const int mi = r / I_Q, q = r % I_Q, kb = q / 18, nb = q % 18;
            transpose_item(a.in[I_WQUP] + (size_t)mi * 256 * 576, 576, kb * 64, nb * 32, (bf16_t*)(ws + WS_WQ + mi * WQ_BYTES), 256, nb * 32, scr, lane); continue; }
        r -= 2 * I_Q;
        if (r < 2 * I_KV) { const int mi = r / I_KV, q = r % I_KV, kb = q / 24, nb = q % 24;
            bf16_t* dst = (bf16_t*)(ws + WS_WKV + mi * WKV_BYTES);
            transpose_item(a.in[I_WKVUP] + (size_t)mi * 128 * 768, 768, kb * 64, nb * 32, dst, 256, nb * 32, scr, lane);
            { const int n = lane >> 1, half = lane & 1; unsigned z0 = 0u; asm volatile("" : "+v"(z0)); const u32x4 z = {z0, z0, z0, z0};
#pragma unroll
              for (int j = 0; j < 4; ++j) *(u32x4*)(dst + (size_t)(nb * 32 + n) * 256 + 128 + kb * 64 + half * 32 + j * 8) = z; }
            continue; }
        r -= 2 * I_KV;
        { const int mi = r / I_G, q = r % I_G, kb = q / 8, nb = q % 8;
            transpose_item(a.in[I_WGLU] + (size_t)mi * 256 * 256, 256, kb * 64, nb * 32, (bf16_t*)(ws + WS_WGLU + mi * WGLU_BYTES), 256, nb * 32, scr, lane); }
    }
}
__device__ __forceinline__ void adaln_item(const Args& a, LAS unsigned char* lds, int item, int tid) {
    LAS float* sc = (LAS float*)lds;
    LAS float* red = (LAS float*)(lds + 20480);
    const int l = item >> 7, col0 = (item & 127) * 72;
    for (int i = tid; i < 5 * 1024; i += NTHR) { const int cd = i >> 10, k = i & 1023; const float v = cd == 0 ? a.in[I_CCTX][k] : a.in[I_C][(cd - 1) * 1024 + k]; sc[i] = v * __builtin_amdgcn_rcpf(1.0f + __expf(-v)); }
    __syncthreads();
    if (tid < 504) {
        const int cg4 = tid % 18, kg = tid / 18;
        const float* wp = a.in[I_WADA] + ((size_t)l * 1024 + kg) * 9216 + col0 + 4 * cg4;
        f32x4 acc[5];
#pragma unroll
        for (int c = 0; c < 5; ++c) acc[c] = (f32x4){0.f, 0.f, 0.f, 0.f};
        const int nk = (1024 - kg + 27) / 28;
#pragma unroll 8
        for (int i = 0; i < nk; ++i) { const f32x4 w = *(const f32x4*)(wp + (size_t)(28 * i) * 9216); const int k = kg + 28 * i;
#pragma unroll
            for (int c = 0; c < 5; ++c) acc[c] += w * sc[c * 1024 + k]; }
#pragma unroll
        for (int c = 0; c < 5; ++c) *(LAS f32x4*)(red + (kg * 5 + c) * 72 + 4 * cg4) = acc[c];
    }
    __syncthreads();
    if (tid < 360) { const int c = tid / 72, col = tid % 72; float s = 0.f;
#pragma unroll
        for (int k = 0; k < 28; ++k) s += red[(k * 5 + c) * 72 + col];
        const int gc = col0 + col;
        ((float*)(a.ws + WS_MOD))[((size_t)l * 5 + c) * 9216 + gc] = s + a.in[I_BADA][(size_t)l * 9216 + gc]; }
    __syncthreads();
}
__device__ __forceinline__ void s5gen_item(const Args& a, LAS unsigned char* lds, int item, int tid) {
    const int l = item >> 4, g = item & 15;
    LAS float* pwr = (LAS float*)lds;
    LAS float* pwi = pwr + 2 * 64 * 17;
    LAS float* bbr = pwi + 2 * 64 * 17;
    LAS float* bbi = bbr + 2 * 64 * 16;
    LAS float* cr = bbi + 2 * 64 * 16;
    LAS float* ci = cr + 2 * 16 * 64;
    LAS float* klag = ci + 2 * 16 * 64;
    if (tid < 128) { const int d = tid >> 6, p = tid & 63; const size_t ix = (((size_t)l * 2 + d) * 16 + g) * 64 + p;
        const float are = a.in[I_ARE][ix], aim = a.in[I_AIM][ix], st = __expf(a.in[I_LSTEP][((size_t)l * 2 + d) * 16 + g]);
        float l1r = 0.f, l1i = 0.f;
        for (int k = 0; k <= 16; ++k) { const float mag = __expf((float)k * are * st); float s, c; sincos_rev((float)k * aim * st, s, c);
            pwr[(d * 64 + p) * 17 + k] = mag * c; pwi[(d * 64 + p) * 17 + k] = mag * s; if (k == 1) { l1r = mag * c; l1i = mag * s; } }
        const float xr = l1r - 1.0f, xi = l1i, den = 1.0f / (are * are + aim * aim);
        const float cfr = (xr * are + xi * aim) * den, cfi = (xi * are - xr * aim) * den;
        for (int c = 0; c < 16; ++c) { const float br = a.in[I_BRE][ix * 16 + c], bi = a.in[I_BIM][ix * 16 + c];
            bbr[(d * 64 + p) * 16 + c] = cfr * br - cfi * bi; bbi[(d * 64 + p) * 16 + c] = cfr * bi + cfi * br; }
    }
    for (int i = tid; i < 2048; i += NTHR) { const int d = i >> 10, co = (i >> 6) & 15, p = i & 63; const size_t ix = ((((size_t)l * 2 + d) * 16 + g) * 16 + co) * 64 + p;
        cr[i] = a.in[I_CRE][ix]; ci[i] = a.in[I_CIM][ix]; }
    __syncthreads();
    for (int i = tid; i < 8192; i += NTHR) { const int d = i >> 12, j = (i >> 8) & 15, co = (i >> 4) & 15, cin = i & 15; float s = 0.f;
        for (int p = 0; p < 64; ++p) { const float c_r = cr[(d * 16 + co) * 64 + p], c_i = ci[(d * 16 + co) * 64 + p], p_r = pwr[(d * 64 + p) * 17 + j], p_i = pwi[(d * 64 + p) * 17 + j];
            const float gr = c_r * p_r - c_i * p_i, gi = c_r * p_i + c_i * p_r; s += gr * bbr[(d * 64 + p) * 16 + cin] - gi * bbi[(d * 64 + p) * 16 + cin]; }
        klag[i] = s; }
    __syncthreads();
    bf16_t* Bc = (bf16_t*)(a.ws + WS_BCAT + (size_t)l * BCAT_BYTES) + (size_t)g * 256 * 512;
    bf16_t* Em = (bf16_t*)(a.ws + WS_E + (size_t)l * E_BYTES) + (size_t)g * 256 * 256;
    const float* Dv = a.in[I_S5D] + ((size_t)l * 16 + g) * 16;
    for (int i = tid; i < 256 * 256; i += NTHR) { const int n = i >> 8, k2 = (i & 255) * 2; const int t = n >> 4, co = n & 15; float v[2];
#pragma unroll
        for (int e = 0; e < 2; ++e) { const int k = k2 + e;
            if (k < 256) { const int s = k >> 4, cin = k & 15; float x = 0.f;
                if (s <= t) x += klag[((0 * 16 + (t - s)) * 16 + co) * 16 + cin];
                if (s >= t) x += klag[((1 * 16 + (s - t)) * 16 + co) * 16 + cin];
                if (s == t && cin == co) x += Dv[co];
                v[e] = x; }
            else { const int kk = k - 256, d = kk >> 7, p = (kk >> 1) & 63, ri = kk & 1, pe = d == 0 ? t + 1 : 16 - t;
                const float c_r = cr[(d * 16 + co) * 64 + p], c_i = ci[(d * 16 + co) * 64 + p], p_r = pwr[(d * 64 + p) * 17 + pe], p_i = pwi[(d * 64 + p) * 17 + pe];
                v[e] = ri == 0 ? (c_r * p_r - c_i * p_i) : -(c_r * p_i + c_i * p_r); } }
        *(unsigned*)(Bc + (size_t)n * 512 + k2) = cvtpk(v[0], v[1]); }
    for (int i = tid; i < 256 * 128; i += NTHR) { const int n = i >> 7, k2 = (i & 127) * 2; const int d = n >> 7, p = (n >> 1) & 63, ri = n & 1; float v[2];
#pragma unroll
        for (int e = 0; e < 2; ++e) { const int k = k2 + e, s = k >> 4, cin = k & 15, pe = d == 0 ? 15 - s : s;
            const float p_r = pwr[(d * 64 + p) * 17 + pe], p_i = pwi[(d * 64 + p) * 17 + pe], b_r = bbr[(d * 64 + p) * 16 + cin], b_i = bbi[(d * 64 + p) * 16 + cin];
            v[e] = ri == 0 ? (p_r * b_r - p_i * b_i) : (p_r * b_i + p_i * b_r); }
        *(unsigned*)(Em + (size_t)n * 256 + k2) = cvtpk(v[0], v[1]); }
    __syncthreads();
}
__device__ __forceinline__ void phase0(const Args& a, LAS unsigned char* lds, int tid, int wave, int lane) {
    const int b = blockIdx.x, G = gridDim.x;
    for (int it = b; it < 256; it += G) adaln_item(a, lds, it, tid);
    if ((b & 7) == 3) for (int it = b >> 3; it < 32; it += (G + 7) >> 3) s5gen_item(a, lds, it, tid);
    if (b == G - 1) { const int pos = tid >> 3, i = tid & 7; const float inv = exp2f(-(float)i * 0.125f * 13.287712379549449f); float s, c; sincos_rev((float)pos * inv, s, c);
        float* rt = (float*)(a.ws + WS_ROPE); rt[(pos * 8 + i) * 2 + 0] = c; rt[(pos * 8 + i) * 2 + 1] = s; }
    __syncthreads();
    convert_weights(a, lds, b * NWAVES + wave, G * NWAVES, wave, lane);
}

__device__ __forceinline__ const float* xrow_ptr(const Args& a, int l, int m) {
    if (l == 0) return m < TC ? a.in[I_XP] + (size_t)m * DM : a.in[I_XS] + (size_t)(m - TC) * DM;
    return a.out + (size_t)m * DM;
}
__device__ __forceinline__ void norm_phase(const Args& a, int l, int j, bool src_inputs, int gw, int ngw, int lane) {
    const float* nw = a.in[I_NORMW] + ((size_t)l * 3 + j) * DM;
    bf16_t* XN = (bf16_t*)(a.ws + WS_XN);
    for (int m0 = gw; m0 < T; m0 += 2 * ngw) {
        const int m1 = m0 + ngw; const bool has1 = m1 < T; const int mm1 = has1 ? m1 : m0;
        const float* xr0 = src_inputs ? xrow_ptr(a, 0, m0) : a.out + (size_t)m0 * DM;
        const float* xr1 = src_inputs ? xrow_ptr(a, 0, mm1) : a.out + (size_t)mm1 * DM;
        f32x4 v0[4], v1[4]; float s0 = 0.f, s1 = 0.f;
#pragma unroll
        for (int q = 0; q < 4; ++q) { v0[q] = ((const f32x4*)xr0)[lane + 64 * q]; v1[q] = ((const f32x4*)xr1)[lane + 64 * q]; }
#pragma unroll
        for (int q = 0; q < 4; ++q) { s0 += (v0[q].x * v0[q].x + v0[q].y * v0[q].y) + (v0[q].z * v0[q].z + v0[q].w * v0[q].w); s1 += (v1[q].x * v1[q].x + v1[q].y * v1[q].y) + (v1[q].z * v1[q].z + v1[q].w * v1[q].w); }
        const float r0 = __builtin_amdgcn_rsqf(wave_sum(s0, lane) * (1.0f / DM) + EPS), r1 = __builtin_amdgcn_rsqf(wave_sum(s1, lane) * (1.0f / DM) + EPS);
        const int c0 = m0 < TC ? 0 : 1 + ((m0 - TC) >> 11), c1 = mm1 < TC ? 0 : 1 + ((mm1 - TC) >> 11);
        const float* md0 = (const float*)(a.ws + WS_MOD) + ((size_t)l * 5 + c0) * 9216 + (size_t)(3 * j) * DM;
        const float* md1 = (const float*)(a.ws + WS_MOD) + ((size_t)l * 5 + c1) * 9216 + (size_t)(3 * j) * DM;
#pragma unroll
        for (int q = 0; q < 4; ++q) { const int ix = lane + 64 * q; const f32x4 w = ((const f32x4*)nw)[ix];
            { const f32x4 sh = ((const f32x4*)md0)[ix], sc = ((const f32x4*)(md0 + DM))[ix]; const f32x4 y = v0[q] * r0 * w * (sc + 1.0f) + sh;
              u32x2 o; o.x = cvtpk(y.x, y.y); o.y = cvtpk(y.z, y.w); ((u32x2*)(XN + (size_t)m0 * DM))[ix] = o; }
            if (has1) { const f32x4 sh = ((const f32x4*)md1)[ix], sc = ((const f32x4*)(md1 + DM))[ix]; const f32x4 y = v1[q] * r1 * w * (sc + 1.0f) + sh;
              u32x2 o; o.x = cvtpk(y.x, y.y); o.y = cvtpk(y.z, y.w); ((u32x2*)(XN + (size_t)m1 * DM))[ix] = o; } }
    }
}
__device__ __forceinline__ void final_norm_phase(const Args& a, int gw, int ngw, int lane) {
    const float* nw = a.in[I_FNW];
    for (int m = gw; m < T; m += ngw) { float* xr = a.out + (size_t)m * DM; f32x4 v[4]; float ss = 0.f;
#pragma unroll
        for (int q = 0; q < 4; ++q) { v[q] = ((const f32x4*)xr)[lane + 64 * q]; ss += (v[q].x * v[q].x + v[q].y * v[q].y) + (v[q].z * v[q].z + v[q].w * v[q].w); }
        const float rinv = __builtin_amdgcn_rsqf(wave_sum(ss, lane) * (1.0f / DM) + EPS);
#pragma unroll
        for (int q = 0; q < 4; ++q) { const int ix = lane + 64 * q; ((f32x4*)xr)[ix] = v[q] * rinv * ((const f32x4*)nw)[ix]; } }
}

#define XB_TMO      128
#define XB_XCNT(j)  (256  + 64 * (j))
#define XB_XSUB(j)  (1280 + 64 * (j))
#define XB_XGEN(j)  (2304 + 64 * (j))
#define XB_TOP      3328
#define XB_TOPGEN   3392
#define XCD_BAR_WORDS 3456
#define XB_SPIN_CAP (1u << 18)

__device__ __forceinline__ unsigned xb_ld(unsigned* p)              { return __hip_atomic_load(p, __ATOMIC_RELAXED, __HIP_MEMORY_SCOPE_AGENT); }
__device__ __forceinline__ unsigned xb_add(unsigned* p, unsigned v) { return __hip_atomic_fetch_add(p, v, __ATOMIC_RELAXED, __HIP_MEMORY_SCOPE_AGENT); }
__device__ __forceinline__ unsigned xb_xcc_id() { return (unsigned)__builtin_amdgcn_s_getreg((3 << 11) | 20) & 0xFu; }
#define XB_SPIN(cond, bar) do { unsigned _sp = 0; while (cond) { __builtin_amdgcn_s_sleep(1); \
    if ((++_sp & 255u) == 0u) { if (xb_ld(&(bar)[XB_TMO])) break; if (_sp > XB_SPIN_CAP) { atomicAdd(&(bar)[XB_TMO], 1u); break; } } } } while (0)

struct XcdBarrier {
    unsigned* bar; unsigned x;
    volatile LAS unsigned* st;
};

__device__ __forceinline__ XcdBarrier xcd_barrier_post(unsigned* bar, volatile LAS unsigned* st, bool leader) {
    XcdBarrier b; b.bar = bar; b.x = xb_xcc_id(); b.st = st;
    if (leader) (void)xb_add(&bar[XB_XCNT(b.x)], 1u);
    return b;
}
__device__ __forceinline__ void xcd_barrier_complete(unsigned* bar, unsigned x, unsigned& nloc, unsigned& nx) {
    const unsigned G = gridDim.x * gridDim.y * gridDim.z;
    unsigned sum, cnt, mine, sp = 0u;
    for (;;) {
        sum = 0u; cnt = 0u; mine = 0u;
#pragma unroll
        for (unsigned j = 0; j < 16; ++j) { const unsigned c = xb_ld(&bar[XB_XCNT(j)]); sum += c; cnt += (c > 0u) ? 1u : 0u; mine = (j == x) ? c : mine; }
        if (sum == G) break;
        __builtin_amdgcn_s_sleep(1);
        if ((++sp & 255u) == 0u) { if (xb_ld(&bar[XB_TMO])) break; if (sp > XB_SPIN_CAP) { atomicAdd(&bar[XB_TMO], 1u); break; } }
    }
    nloc = mine > 0u ? mine : 1u; nx = cnt > 0u ? cnt : 1u;
}

__device__ __forceinline__ void xcd_barrier(const XcdBarrier& b, bool leader) {
    asm volatile("s_waitcnt vmcnt(0)" ::: "memory");
    __syncthreads();
    if (leader) {
        unsigned* bar = b.bar;
        __builtin_amdgcn_s_waitcnt(0);
        unsigned nloc = b.st[0], nx = b.st[1];
        if (nloc == 0u) { xcd_barrier_complete(bar, b.x, nloc, nx); b.st[0] = nloc; b.st[1] = nx; }
        const unsigned old = xb_add(&bar[XB_XSUB(b.x)], 1u);
        const unsigned gen = old / nloc;
        if (old + 1u == (gen + 1u) * nloc) {
            __builtin_amdgcn_fence(__ATOMIC_RELEASE, "agent");
            asm volatile("s_waitcnt vmcnt(0)" ::: "memory");
            const unsigned og = xb_add(&bar[XB_TOP], 1u);
            const unsigned tg = og / nx;
            if (og + 1u == (tg + 1u) * nx) xb_add(&bar[XB_TOPGEN], 1u);
            else XB_SPIN(xb_ld(&bar[XB_TOPGEN]) == tg, bar);
            __builtin_amdgcn_fence(__ATOMIC_ACQUIRE, "agent");
            xb_add(&bar[XB_XGEN(b.x)], 1u);
            asm volatile("s_waitcnt vmcnt(0)" ::: "memory");
        } else {
            XB_SPIN(xb_ld(&bar[XB_XGEN(b.x)]) == gen, bar);
            __builtin_amdgcn_fence(__ATOMIC_ACQUIRE, "agent");
            asm volatile("s_waitcnt vmcnt(0)" ::: "memory");
        }
    }
    __syncthreads();
}

__device__ __forceinline__ void post_phase(const Args& a, int l, int gw, int ngw, int lane) {
    unsigned char* ws = a.ws;
    const bf16_t* P = (const bf16_t*)(ws + WS_P);
    bf16_t* QD = (bf16_t*)(ws + WS_QD); bf16_t* KD = (bf16_t*)(ws + WS_KD); bf16_t* VD = (bf16_t*)(ws + WS_VD);
    bf16_t* CQN = (bf16_t*)(ws + WS_CQN); bf16_t* CKVN = (bf16_t*)(ws + WS_CKVN); bf16_t* KPE = (bf16_t*)(ws + WS_KPE); bf16_t* A2 = (bf16_t*)(ws + WS_A2);
    const float* rope = (const float*)(ws + WS_ROPE);
    const float* qnw = a.in[I_QNW] + (size_t)l * 256; const float* kvnw = a.in[I_KVNW] + (size_t)l * 128;
    const float QS = 0.17677669529663687f * 1.4426950408889634f;
    for (int m = gw; m < T + 1024; m += ngw) {
        if (m >= T) {
            const int r = m - T, b = r >> 8, s = r & 255; const size_t kr = 8192 + (size_t)b * 2304 + 2048 + s;
            const size_t src = ((size_t)(b * 2 + l) * 256 + s);
            const float* ck = a.in[I_CDK] + src * 384; const float* cv = a.in[I_CDV] + src * 384;
#pragma unroll
            for (int q = 0; q < 3; ++q) { const int j = 2 * (lane + 64 * q);
                *(unsigned*)(KD + kr * 384 + j) = cvtpk(ck[j], ck[j + 1]); *(unsigned*)(VD + kr * 384 + j) = cvtpk(cv[j], cv[j + 1]); }
            const float* cc = a.in[I_CCKV] + src * 128; *(unsigned*)(CKVN + kr * 256 + 2 * lane) = cvtpk(cc[2 * lane], cc[2 * lane + 1]); *(unsigned*)(CKVN + kr * 256 + 128 + 2 * lane) = 0u;
            if (lane < 16) { const float* cp = a.in[I_CKPE] + src * 32; *(unsigned*)(KPE + kr * 32 + 2 * lane) = cvtpk(cp[2 * lane], cp[2 * lane + 1]); }
            continue;
        }
        const bool lat = m >= TC;
        int b = 0, t = 0; if (lat) { b = (m - TC) >> 11; t = (m - TC) & 2047; }
        const size_t kr = lat ? 8192 + (size_t)b * 2304 + t : (size_t)m;
        const int prow = t >> 6, pcol = t & 63;
        const size_t orow = ((size_t)((m >> 8) * 2 + l) * 256 + (m & 255));
        const u32x4* pr = (const u32x4*)(P + (size_t)m * 2048);
#pragma unroll
        for (int i = 0; i < 4; ++i) {
            const int c = lane + 64 * i;
            const u32x4 raw = pr[c];
            float v[8], pv[8]; unpack8(raw, v);
#pragma unroll
            for (int e = 0; e < 8; ++e) pv[e] = shx(v[e], 1, lane);
            float rv[8];
            { const int pos = (c & 2) ? pcol : prow; const f32x4* rp = (const f32x4*)(rope + pos * 16);
#pragma unroll
              for (int e2 = 0; e2 < 4; ++e2) { f32x4 cs = rp[e2];
                  if (!lat) cs = (f32x4){1.0f, 0.0f, 1.0f, 0.0f};
                  if (c & 1) { rv[2 * e2] = pv[2 * e2] * cs.y + v[2 * e2] * cs.x; rv[2 * e2 + 1] = pv[2 * e2 + 1] * cs.w + v[2 * e2 + 1] * cs.z; }
                  else       { rv[2 * e2] = v[2 * e2] * cs.x - pv[2 * e2] * cs.y; rv[2 * e2 + 1] = v[2 * e2 + 1] * cs.z - pv[2 * e2 + 1] * cs.w; } } }
            float ssq = 0.f, sskv = 0.f;
            if (i == 2) { float s = 0.f;
#pragma unroll
                for (int e = 0; e < 8; ++e) s += v[e] * v[e];
                ssq = wave_sum((lane >= 16 && lane < 48) ? s : 0.f, lane); sskv = wave_sum(lane >= 48 ? s : 0.f, lane); }
            if (c < 48) {
                float o[8];
#pragma unroll
                for (int e = 0; e < 8; ++e) o[e] = rv[e] * QS;
                *(u32x4*)(QD + (size_t)m * 384 + 8 * c) = pack8(o);
            } else if (c < 96) {
                const int cs = c - 48;
                *(u32x4*)(KD + kr * 384 + 8 * cs) = pack8(rv);
                if (!lat) { float* o = a.out + OUT_DK + orow * 384 + 8 * cs;
                       *(f32x4*)o = (f32x4){v[0], v[1], v[2], v[3]}; *(f32x4*)(o + 4) = (f32x4){v[4], v[5], v[6], v[7]}; }
            } else if (c < 144) {
                const int cs = c - 96;
                *(u32x4*)(VD + kr * 384 + 8 * cs) = raw;
                if (!lat) { float* o = a.out + OUT_DV + orow * 384 + 8 * cs; *(f32x4*)o = (f32x4){v[0], v[1], v[2], v[3]}; *(f32x4*)(o + 4) = (f32x4){v[4], v[5], v[6], v[7]}; }
            } else if (c < 176) {
                const int cs = c - 144; const float rinv = __builtin_amdgcn_rsqf(ssq * (1.0f / 256.0f) + EPS); float o[8];
#pragma unroll
                for (int e = 0; e < 8; ++e) o[e] = v[e] * rinv * qnw[8 * cs + e];
                *(u32x4*)(CQN + (size_t)m * 256 + 8 * cs) = pack8(o);
            } else if (c < 192) {
                const int cs = c - 176; const float rinv = __builtin_amdgcn_rsqf(sskv * (1.0f / 128.0f) + EPS); float o[8];
#pragma unroll
                for (int e = 0; e < 8; ++e) o[e] = v[e] * rinv * kvnw[8 * cs + e];
                *(u32x4*)(CKVN + kr * 256 + 8 * cs) = pack8(o); { unsigned z = 0u; asm volatile("" : "+v"(z)); *(u32x4*)(CKVN + kr * 256 + 128 + 8 * cs) = (u32x4){z, z, z, z}; }
                if (!lat) { float* op = a.out + OUT_CKV + orow * 128 + 8 * cs; *(f32x4*)op = (f32x4){o[0], o[1], o[2], o[3]}; *(f32x4*)(op + 4) = (f32x4){o[4], o[5], o[6], o[7]}; }
            } else if (c < 196) {
                const int cs = c - 192;
                *(u32x4*)(KPE + kr * 32 + 8 * cs) = pack8(rv);
                if (!lat) { float* op = a.out + OUT_KPE + orow * 32 + 8 * cs;
                       *(f32x4*)op = (f32x4){v[0], v[1], v[2], v[3]}; *(f32x4*)(op + 4) = (f32x4){v[4], v[5], v[6], v[7]}; }
            } else if (c < 228) {
                const int cs = c - 196, g = cs >> 1;
                *(u32x4*)(A2 + ((size_t)g * 1024 + (m >> 4)) * 512 + (m & 15) * 16 + (cs & 1) * 8) = raw;
            }
        }
    }
}

__device__ __forceinline__ void s5_combine_phase(const Args& a, int l, int gw, int ngw, int lane) {
    const float* S = (const float*)(a.ws + WS_S); bf16_t* A2 = (bf16_t*)(a.ws + WS_A2);
    for (int w = gw; w < 36 * 32; w += ngw) {
        const int seq = w >> 5, g = (w >> 1) & 15, d = w & 1, p = lane;
        const size_t ix = (((size_t)l * 2 + d) * 16 + g) * 64 + p;
        const float are = a.in[I_ARE][ix], aim = a.in[I_AIM][ix], st = __expf(a.in[I_LSTEP][((size_t)l * 2 + d) * 16 + g]);
        const float mag = __expf(16.0f * are * st); float sn, cs; sincos_rev(16.0f * aim * st, sn, cs);
        const float lr = mag * cs, li = mag * sn;
        const bool lat = seq >= 32; const int nch = lat ? 128 : 16; const int row0 = lat ? 512 + (seq - 32) * 128 : seq * 16;
        float hr = 0.f, hi = 0.f;
        if (lat) { const size_t six = ((((size_t)(seq - 32) * 2 + l) * 2 + d) * 16 + g) * 64 + p; hr = a.in[I_SRE][six]; hi = a.in[I_SIM][six]; }
        for (int cc = 0; cc < nch; ++cc) { const int ch = d == 0 ? cc : nch - 1 - cc; const size_t row = (size_t)g * 1024 + row0 + ch;
            *(unsigned*)(A2 + row * 512 + 256 + d * 128 + 2 * p) = cvtpk(hr, hi);
            const f32x2_t s = *(const f32x2_t*)(S + row * 256 + d * 128 + 2 * p);
            const float nr = lr * hr - li * hi + s.x, ni = lr * hi + li * hr + s.y; hr = nr; hi = ni; }
        if (!lat) { const size_t oix = ((((size_t)seq * 2 + l) * 2 + d) * 16 + g) * 64 + p; a.out[OUT_SRE + oix] = hr; a.out[OUT_SIM + oix] = hi; }
    }
}

struct AttnState { float m, l; f32x16 o[2]; };
__device__ __forceinline__ bf16x8 vfrag(const LAS bf16_t* vb) {
    typedef short v4i16_t __attribute__((ext_vector_type(4)));
    const s16x4 lo = __builtin_bit_cast(s16x4, __builtin_amdgcn_ds_read_tr16_b64_v4i16((LAS v4i16_t*)vb));
    const s16x4 hi = __builtin_bit_cast(s16x4, __builtin_amdgcn_ds_read_tr16_b64_v4i16((LAS v4i16_t*)(vb + 256)));
    return (bf16x8){lo[0], lo[1], lo[2], lo[3], hi[0], hi[1], hi[2], hi[3]};
}
template <int NK>
__device__ __forceinline__ void attn_tile(AttnState& st, const LAS bf16_t* Kl, int kstr, int koff, const bf16x8* qf, const LAS bf16_t* vrd, int lane) {
    const int r32 = lane & 31, hi = lane >> 5;
    f32x16 s0, s1;
#pragma unroll
    for (int e = 0; e < 16; ++e) { s0[e] = 0.f; s1[e] = 0.f; }
    const LAS bf16_t* kp = Kl + r32 * kstr + koff + 8 * hi;
#pragma unroll
    for (int ks = 0; ks < NK; ++ks) {
        const bf16x8 k0 = *(const LAS bf16x8*)(kp + 16 * ks), k1 = *(const LAS bf16x8*)(kp + 32 * kstr + 16 * ks);
        s0 = __builtin_amdgcn_mfma_f32_32x32x16_bf16(k0, qf[ks], s0, 0, 0, 0);
        s1 = __builtin_amdgcn_mfma_f32_32x32x16_bf16(k1, qf[ks], s1, 0, 0, 0);
    }
    float mx = s0[0];
#pragma unroll
    for (int e = 1; e < 16; ++e) mx = fmaxf(mx, s0[e]);
#pragma unroll
    for (int e = 0; e < 16; ++e) mx = fmaxf(mx, s1[e]);
    mx = fmaxf(mx, shx(mx, 32, lane));
    const float mnew = fmaxf(st.m, mx), alpha = __builtin_amdgcn_exp2f(st.m - mnew); st.m = mnew;
    float rs = 0.f;
#pragma unroll
    for (int e = 0; e < 16; ++e) { s0[e] = __builtin_amdgcn_exp2f(s0[e] - mnew); s1[e] = __builtin_amdgcn_exp2f(s1[e] - mnew); rs += s0[e] + s1[e]; }
    st.l = st.l * alpha + rs;
#pragma unroll
    for (int e = 0; e < 16; ++e) { st.o[0][e] *= alpha; st.o[1][e] *= alpha; }
    bf16x8 pb[2][2];
#pragma unroll
    for (int s = 0; s < 2; ++s) {
        u32x4 w0; w0.x = cvtpk(s0[8 * s + 0], s0[8 * s + 1]); w0.y = cvtpk(s0[8 * s + 2], s0[8 * s + 3]); w0.z = cvtpk(s0[8 * s + 4], s0[8 * s + 5]); w0.w = cvtpk(s0[8 * s + 6], s0[8 * s + 7]);
        u32x4 w1; w1.x = cvtpk(s1[8 * s + 0], s1[8 * s + 1]); w1.y = cvtpk(s1[8 * s + 2], s1[8 * s + 3]); w1.z = cvtpk(s1[8 * s + 4], s1[8 * s + 5]); w1.w = cvtpk(s1[8 * s + 6], s1[8 * s + 7]);
        pb[0][s] = __builtin_bit_cast(bf16x8, w0); pb[1][s] = __builtin_bit_cast(bf16x8, w1);
    }
#pragma unroll
    for (int db = 0; db < 2; ++db)
#pragma unroll
        for (int kb = 0; kb < 2; ++kb)
#pragma unroll
            for (int s = 0; s < 2; ++s) st.o[db] = __builtin_amdgcn_mfma_f32_32x32x16_bf16(vfrag(vrd + db * 2048 + (32 * kb + 16 * s) * 32), pb[kb][s], st.o[db], 0, 0, 0);
}
template <int MODE>
__device__ __forceinline__ void attn_item(const Args& a, LAS unsigned char* lds, int l, int ksp, int h, int qt, float lam, float lam_init, int tid, int wave, int lane) {
    constexpr int KSTR = MODE == 0 ? 72 : 104;
    unsigned char* ws = a.ws;
    LAS bf16_t* Kl = (LAS bf16_t*)lds; LAS bf16_t* Vl = (LAS bf16_t*)(lds + 13312);
    const bool lat = ksp >= 32;
    const int nt = lat ? 36 : 4;
    const size_t keyrow0 = lat ? 8192 + (size_t)(ksp - 32) * 2304 : (size_t)ksp * 256;
    const int qrow0 = lat ? TC + (ksp - 32) * 2048 + qt * 256 : ksp * 256;
    const int r32 = lane & 31, hi = lane >> 5;
    const int qrow = qrow0 + 32 * wave + r32;
    const bf16_t* Ksrc; const bf16_t* Vsrc; const bf16_t* Psrc = nullptr; int kvs;
    if (MODE == 0) { Ksrc = (const bf16_t*)(ws + WS_KD) + keyrow0 * 384 + h * 64; Vsrc = (const bf16_t*)(ws + WS_VD) + keyrow0 * 384 + h * 64; kvs = 384; }
    else { Ksrc = (const bf16_t*)(ws + WS_KV) + keyrow0 * 768 + h * 128; Vsrc = Ksrc + 64; Psrc = (const bf16_t*)(ws + WS_KPE) + keyrow0 * 32; kvs = 768; }
    constexpr int NQF = MODE == 0 ? 4 : 6;
    bf16x8 qf[NQF];
    if (MODE == 0) { const bf16_t* qp = (const bf16_t*)(ws + WS_QD) + (size_t)qrow * 384 + h * 64 + 8 * hi;
#pragma unroll
        for (int f = 0; f < 4; ++f) qf[f] = *(const bf16x8*)(qp + 16 * f); }
    else { const float QS1 = 0.10206207261596577f * 1.4426950408889634f;
        const bf16_t* qp = (const bf16_t*)(ws + WS_Q2) + (size_t)qrow * 768 + h * 96;
        const int t = (qrow - TC) & 2047; const float* rope = (const float*)(ws + WS_ROPE);
#pragma unroll
        for (int f = 0; f < 6; ++f) { float o[8];
            if (f < 4) { float v[8]; unpack8(*(const u32x4*)(qp + 16 * f + 8 * hi), v);
#pragma unroll
                for (int e = 0; e < 8; ++e) o[e] = v[e] * QS1; }
            else { float x1[8], x2[8]; unpack8(*(const u32x4*)(qp + 16 * f), x1); unpack8(*(const u32x4*)(qp + 16 * f + 8), x2);
                const int pos = f == 4 ? (t >> 6) : (t & 63); const float* rp = rope + pos * 16;
#pragma unroll
                for (int e = 0; e < 8; ++e) { const float cs = lat ? rp[2 * e] : 1.0f, sn = lat ? rp[2 * e + 1] : 0.0f;
                    o[e] = (hi == 0 ? x1[e] * cs - x2[e] * sn : x1[e] * sn + x2[e] * cs) * QS1; } }
            qf[f] = __builtin_bit_cast(bf16x8, pack8(o)); } }
    AttnState st0, st1;
    st0.m = -1e30f; st0.l = 0.f; st1.m = -1e30f; st1.l = 0.f;
#pragma unroll
    for (int e = 0; e < 16; ++e) { st0.o[0][e] = 0.f; st0.o[1][e] = 0.f; st1.o[0][e] = 0.f; st1.o[1][e] = 0.f; }
    const int key = tid >> 3, ch = tid & 7;
    const bf16_t* kg = Ksrc + (size_t)key * kvs + 8 * ch; const bf16_t* vg = Vsrc + (size_t)key * kvs + 8 * ch;
    const bf16_t* pg = MODE == 1 ? Psrc + (size_t)(tid >> 2) * 32 + 8 * (tid & 3) : nullptr;
    LAS bf16_t* kl = Kl + key * KSTR + 8 * ch; LAS bf16_t* vl = Vl + (ch >> 2) * 2048 + key * 32 + 8 * (ch & 3);
    LAS bf16_t* pl = Kl + (tid >> 2) * KSTR + 64 + 8 * (tid & 3);
    u32x4 kreg = *(const u32x4*)kg, vreg = *(const u32x4*)vg, preg;
    if (MODE == 1) preg = *(const u32x4*)(tid < 256 ? pg : kg);
    const LAS bf16_t* vrd = Vl + (4 * hi + ((lane & 15) >> 2)) * 32 + 16 * ((lane >> 4) & 1) + 4 * (lane & 3);
    for (int kt = 0; kt < nt; ++kt) {
        __syncthreads();
        *(LAS u32x4*)kl = kreg; *(LAS u32x4*)vl = vreg; if (MODE == 1 && tid < 256) *(LAS u32x4*)pl = preg;
        __syncthreads();
        if (kt + 1 < nt) { const size_t adv = (size_t)(kt + 1) * 64; kreg = *(const u32x4*)(kg + adv * kvs); vreg = *(const u32x4*)(vg + adv * kvs); if (MODE == 1) preg = *(const u32x4*)(tid < 256 ? pg + adv * 32 : kg); }
        if (MODE == 0) { attn_tile<2>(st0, Kl, KSTR, 0, qf, vrd, lane); attn_tile<2>(st1, Kl, KSTR, 32, qf + 2, vrd, lane); }
        else attn_tile<6>(st0, Kl, KSTR, 0, qf, vrd, lane);
    }
    bf16_t* Ob = (bf16_t*)(ws + WS_XN) + (size_t)qrow * 1024 + (MODE == 0 ? 0 : 384) + h * 64;
    const float l0 = st0.l + shx(st0.l, 32, lane); const float i0 = 1.0f / l0;
    float o[2][16];
    if (MODE == 0) {
        const float l1 = st1.l + shx(st1.l, 32, lane); const float i1 = lam / l1; float ss = 0.f;
#pragma unroll
        for (int db = 0; db < 2; ++db)
#pragma unroll
            for (int e = 0; e < 16; ++e) { const float v = st0.o[db][e] * i0 - st1.o[db][e] * i1; o[db][e] = v; ss += v * v; }
        ss += shx(ss, 32, lane);
        const float rinv = __builtin_amdgcn_rsqf(ss * (1.0f / 64.0f) + EPS) * (1.0f - lam_init);
        const float* sw = a.in[I_SUBLN] + (size_t)l * 64;
#pragma unroll
        for (int db = 0; db < 2; ++db)
#pragma unroll
            for (int e = 0; e < 16; ++e) o[db][e] *= rinv * sw[32 * db + (e & 3) + 8 * (e >> 2) + 4 * hi];
    } else {
#pragma unroll
        for (int db = 0; db < 2; ++db)
#pragma unroll
            for (int e = 0; e < 16; ++e) o[db][e] = st0.o[db][e] * i0;
    }
#pragma unroll
    for (int db = 0; db < 2; ++db)
#pragma unroll
        for (int rg = 0; rg < 4; ++rg) { u32x2 w; w.x = cvtpk(o[db][4 * rg], o[db][4 * rg + 1]); w.y = cvtpk(o[db][4 * rg + 2], o[db][4 * rg + 3]);
            *(u32x2*)(Ob + 32 * db + 8 * rg + 4 * hi) = w; }
}

__global__ void __launch_bounds__(NTHR, 2) mega_fwd(Args a) {
    extern __shared__ __attribute__((aligned(16))) unsigned char lds_raw[];
    LAS unsigned char* lds0 = (LAS unsigned char*)lds_raw;
    LAS unsigned char* lds = lds0 + 1024;
    cg::grid_group grid = cg::this_grid();
    const int G = gridDim.x, bx = blockIdx.x, ngw = G * NWAVES;
    const int wave0 = __builtin_amdgcn_readfirstlane((int)threadIdx.x >> 6);
    ArgTab tab = (ArgTab)lds0;
    if (threadIdx.x == 0) {
#pragma unroll
        for (int i = 0; i < 34; ++i) tab[i] = (unsigned long long)a.in[i];
        tab[34] = (unsigned long long)a.out; tab[35] = (unsigned long long)a.ws;
    }
    if (threadIdx.x < 2) ((LAS unsigned*)(lds0 + 512))[threadIdx.x] = 0u;
    __syncthreads();
    (void)xcd_barrier_post((unsigned*)(a.ws + WS_CTL) + CW_BAR, (volatile LAS unsigned*)(lds0 + 512), threadIdx.x == 0);
#define PH_BEGIN LAS unsigned char* tb_ = lds0; asm volatile("" : "+v"(tb_)); const Args b = load_args((ArgTab)tb_); int tid = wave0 * 64 + (int)__builtin_amdgcn_mbcnt_hi(~0u, __builtin_amdgcn_mbcnt_lo(~0u, 0u)); asm volatile("" : "+v"(tid)); const int lane = tid & 63, wave = __builtin_amdgcn_readfirstlane(tid >> 6), gw = bx * NWAVES + wave; unsigned char* ws = b.ws; (void)lane; (void)gw; (void)ws;
#define GSYNC() do { PH_BEGIN XcdBarrier bb_; bb_.bar = (unsigned*)(ws + WS_CTL) + CW_BAR; bb_.x = xb_xcc_id(); bb_.st = (volatile LAS unsigned*)(lds0 + 512); xcd_barrier(bb_, tid == 0); } while (0)
    { PH_BEGIN phase0(b, lds, tid, wave, lane); }
    grid.sync();
    for (int l = 0; l < 2; ++l) {
        { PH_BEGIN norm_phase(b, l, 0, l == 0, gw, ngw, lane); }
        GSYNC();
        { PH_BEGIN pg8::Gemm g{(const bf16_t*)(ws + WS_XN), (const bf16_t*)(ws + WS_W1 + (size_t)(l * 2 + 0) * W1_BYTES), T, 5632, 1024, 1024, 1024}; pg8::StaticOrder S; S.init(T, 5632, G, bx);
          pg8::EpiSwiglu E{(bf16_t*)(ws + WS_H)}; pg8::gemm_phase<pg8::EpiSwiglu, pg8::StaticOrder, true, true>(lds, g, S, E, tid); }
        GSYNC();
        { PH_BEGIN pg8::Gemm g{(const bf16_t*)(ws + WS_H), (const bf16_t*)(ws + WS_W2 + (size_t)(l * 2 + 0) * W2_BYTES), T, 1024, 2816, 2816, 2816}; pg8::StaticOrder S; S.init(T, 1024, G, bx);
          pg8::EpiResid E{l == 0 ? b.in[I_XP] : b.out, l == 0 ? b.in[I_XS] : b.out + (size_t)TC * DM, b.out, (const float*)(ws + WS_MOD) + (size_t)l * 5 * 9216 + 2 * DM, 0.5f};
          pg8::gemm_phase<pg8::EpiResid, pg8::StaticOrder, true, true>(lds, g, S, E, tid); }
        GSYNC();
        { PH_BEGIN norm_phase(b, l, 1, false, gw, ngw, lane); }
        GSYNC();
        { PH_BEGIN pg8::Gemm g{(const bf16_t*)(ws + WS_XN), (const bf16_t*)(ws + WS_WIN + (size_t)l * WIN_BYTES), T, 2048, 1024, 1024, 1024}; pg8::StaticOrder S; S.init(T, 2048, G, bx);
          pg8::EpiBf16 E{(bf16_t*)(ws + WS_P), 2048}; pg8::gemm_phase<pg8::EpiBf16, pg8::StaticOrder, true, true>(lds, g, S, E, tid); }
        GSYNC();
        { PH_BEGIN post_phase(b, l, gw, ngw, lane); }
        GSYNC();
        { PH_BEGIN pg8::Gemm g{(const bf16_t*)(ws + WS_CQN), (const bf16_t*)(ws + WS_WQ + (size_t)l * WQ_BYTES), T, 768, 256, 256, 256}; pg8::StaticOrder S; S.init(T, 768, G, bx);
          pg8::EpiBf16 E{(bf16_t*)(ws + WS_Q2), 768}; pg8::gemm_phase<pg8::EpiBf16, pg8::StaticOrder, true, true>(lds, g, S, E, tid); }
        { PH_BEGIN pg8::Gemm g{(const bf16_t*)(ws + WS_CKVN), (const bf16_t*)(ws + WS_WKV + (size_t)l * WKV_BYTES), KR, 768, 256, 256, 256}; pg8::StaticOrder S; S.init(KR, 768, G, (bx + 64) % G);
          pg8::EpiBf16 E{(bf16_t*)(ws + WS_KV), 768}; pg8::gemm_phase<pg8::EpiBf16, pg8::StaticOrder, true, true>(lds, g, S, E, tid); }
        { PH_BEGIN pg8::Gemm g{(const bf16_t*)(ws + WS_A2), (const bf16_t*)(ws + WS_E + (size_t)l * E_BYTES), 16384, 4096, 256, 512, 256}; pg8::GroupOrder S{64, G, (bx + 116) % G};
          pg8::EpiS5State E{(float*)(ws + WS_S)}; pg8::gemm_phase<pg8::EpiS5State, pg8::GroupOrder, true, true>(lds, g, S, E, tid); }
        GSYNC();
        { PH_BEGIN s5_combine_phase(b, l, gw, ngw, lane); }
        GSYNC();
        { PH_BEGIN pg8::Gemm g{(const bf16_t*)(ws + WS_A2), (const bf16_t*)(ws + WS_BCAT + (size_t)l * BCAT_BYTES), 16384, 4096, 512, 512, 512}; pg8::GroupOrder S{64, G, bx};
          pg8::EpiS5Y E{(bf16_t*)(ws + WS_CQN)}; pg8::gemm_phase<pg8::EpiS5Y, pg8::GroupOrder, true, true>(lds, g, S, E, tid); }
        {
            PH_BEGIN
            unsigned* ctl = (unsigned*)(ws + WS_CTL);
            const float lam_init = 0.8f - 0.6f * __expf(-0.3f * (float)l);
            const float* lp = b.in[I_DLAM] + (size_t)l * 128;
            float pr = lane < 32 ? lp[lane] * lp[32 + lane] : lp[64 + lane - 32] * lp[96 + lane - 32];
#pragma unroll
            for (int o = 1; o < 32; o <<= 1) pr += shx(pr, o, lane);
            const float lam = __expf(__builtin_bit_cast(float, __builtin_amdgcn_readlane(__builtin_bit_cast(int, pr), 0))) - __expf(__builtin_bit_cast(float, __builtin_amdgcn_readlane(__builtin_bit_cast(int, pr), 32))) + lam_init;
            volatile LAS int* qslot = (volatile LAS int*)(lds + 24576);
            for (;;) {
                __syncthreads();
                if (tid == 0) *qslot = (int)atomicAdd(ctl + CW_Q + 64 * l, 1u);
                __syncthreads();
                const int it = *qslot;
                if (it >= 384) break;
                const bool heavy = it < 192; const int j = heavy ? it : it - 192;
                attn_item<0>(b, lds, l, heavy ? 32 + j / 48 : j / 6, heavy ? (j % 48) >> 3 : j % 6, heavy ? (j & 7) : 0, lam, lam_init, tid, wave, lane);
            }
        }
        {
            PH_BEGIN
            unsigned* ctl = (unsigned*)(ws + WS_CTL);
            volatile LAS int* qslot = (volatile LAS int*)(lds + 24576);
            for (;;) {
                __syncthreads();
                if (tid == 0) *qslot = (int)atomicAdd(ctl + CW_Q + 64 * (2 + l), 1u);
                __syncthreads();
                const int it = *qslot;
                if (it >= 384) break;
                const bool heavy = it < 192; const int j = heavy ? it : it - 192;
                attn_item<1>(b, lds, l, heavy ? 32 + j / 48 : j / 6, heavy ? (j % 48) >> 3 : j % 6, heavy ? (j & 7) : 0, 0.f, 0.f, tid, wave, lane);
            }
        }
        GSYNC();
        { PH_BEGIN pg8::Gemm g{(const bf16_t*)(ws + WS_CQN), (const bf16_t*)(ws + WS_WGLU + (size_t)l * WGLU_BYTES), T, 256, 256, 256, 256}; pg8::StaticOrder S; S.init(T, 256, G, bx);
          pg8::EpiGlu E{(const bf16_t*)(ws + WS_CQN), b.in[I_BGLU] + (size_t)l * 256, (bf16_t*)(ws + WS_XN)}; pg8::gemm_phase<pg8::EpiGlu, pg8::StaticOrder, true, true>(lds, g, S, E, tid); }
        GSYNC();
        { PH_BEGIN pg8::Gemm g{(const bf16_t*)(ws + WS_XN), (const bf16_t*)(ws + WS_WOUT + (size_t)l * WOUT_BYTES), T, 1024, 1024, 1024, 1024}; pg8::StaticOrder S; S.init(T, 1024, G, bx);
          pg8::EpiResid E{b.out, b.out + (size_t)TC * DM, b.out, (const float*)(ws + WS_MOD) + (size_t)l * 5 * 9216 + 5 * DM, 1.0f};
          pg8::gemm_phase<pg8::EpiResid, pg8::StaticOrder, true, true>(lds, g, S, E, tid); }
        GSYNC();
        { PH_BEGIN norm_phase(b, l, 2, false, gw, ngw, lane); }
        GSYNC();
        { PH_BEGIN pg8::Gemm g{(const bf16_t*)(ws + WS_XN), (const bf16_t*)(ws + WS_W1 + (size_t)(l * 2 + 1) * W1_BYTES), T, 5632, 1024, 1024, 1024}; pg8::StaticOrder S; S.init(T, 5632, G, bx);
          pg8::EpiSwiglu E{(bf16_t*)(ws + WS_H)}; pg8::gemm_phase<pg8::EpiSwiglu, pg8::StaticOrder, true, true>(lds, g, S, E, tid); }
        GSYNC();
        { PH_BEGIN pg8::Gemm g{(const bf16_t*)(ws + WS_H), (const bf16_t*)(ws + WS_W2 + (size_t)(l * 2 + 1) * W2_BYTES), T, 1024, 2816, 2816, 2816}; pg8::StaticOrder S; S.init(T, 1024, G, bx);
          pg8::EpiResid E{b.out, b.out + (size_t)TC * DM, b.out, (const float*)(ws + WS_MOD) + (size_t)l * 5 * 9216 + 8 * DM, 0.5f};
          pg8::gemm_phase<pg8::EpiResid, pg8::StaticOrder, true, true>(lds, g, S, E, tid); }
        GSYNC();
    }
    { PH_BEGIN final_norm_phase(b, gw, ngw, lane); }
}

extern "C" void kernel_launch(void* const* d_in, const int* in_sizes, int n_in, void* d_out, int out_size, void* d_ws, size_t ws_size, hipStream_t stream) {
    static int grid = 0;
    if (grid == 0) {
        if (n_in != 34 || ws_size < WS_END) { fprintf(stderr, "kernel_launch: expected 34 inputs and >= %zu bytes of workspace; got %d, %zu\n", (size_t)WS_END, n_in, ws_size); grid = -1; return; }
        int dev = 0, cus = 0, per_cu = 0;
        if (hipGetDevice(&dev) != hipSuccess || hipDeviceGetAttribute(&cus, hipDeviceAttributeMultiprocessorCount, dev) != hipSuccess) { grid = -1; return; }
        if (hipFuncSetAttribute((const void*)mega_fwd, hipFuncAttributeMaxDynamicSharedMemorySize, LDS_BYTES) != hipSuccess) { fprintf(stderr, "kernel_launch: hipFuncSetAttribute failed\n"); grid = -1; return; }
        if (hipOccupancyMaxActiveBlocksPerMultiprocessor(&per_cu, (const void*)mega_fwd, NTHR, LDS_BYTES) != hipSuccess || per_cu < 1) { fprintf(stderr, "kernel_launch: occupancy query reports %d\n", per_cu); per_cu = 1; }
        (void)hipGetLastError();
        grid = cus * 1;
    }
    if (grid < 0) return;
    (void)hipMemsetAsync((char*)d_ws + WS_CTL, 0, CTL_BYTES, stream);
    Args a{};
    for (int i = 0; i < 34; ++i) a.in[i] = (const float*)d_in[i];
    a.out = (float*)d_out; a.ws = (unsigned char*)d_ws;
    void* params[] = {&a};
    hipError_t e = hipLaunchCooperativeKernel((const void*)mega_fwd, dim3(grid), dim3(NTHR), params, LDS_BYTES, stream);
    if (e != hipSuccess) fprintf(stderr, "cooperative launch failed: %s (grid %d)\n", hipGetErrorString(e), grid);
}
```
